# Optimizing an MI355X kernel written in HIP

```python
import jax, jax.numpy as jnp
from jax import lax
import numpy as np

D_MODEL = 1024
BATCH = 8
SEQ = 2048
DEPTH = 4

POOL_GROUPS = 4
POOL_GROUP_DIM = 128
POOL_WIDTH = POOL_GROUPS * POOL_GROUP_DIM
POOL_WINDOWS = (2, 4, 8, 16)
LRU_HEADS = 10
LRU_HEAD_DIM = 128
LRU_WIDTH = LRU_HEADS * LRU_HEAD_DIM
CONV_WIDTH = 4
LRU_C = 8.0
D_FF = 2816
EPS = 1e-6
IN_WIDTH = POOL_WIDTH + 2 * LRU_WIDTH + 2 * D_MODEL

kernel_name = "macaron_pool_rglru_gated_hybrid"


def rmsnorm(x, g):
    xf = x.astype(jnp.float32)
    var = jnp.mean(xf * xf, axis=-1, keepdims=True)
    return (xf * lax.rsqrt(var + EPS) * g.astype(jnp.float32)).astype(x.dtype)


def swiglu_ffn(h, w_up, w_down):
    u = h @ w_up
    a, b = jnp.split(u, 2, axis=-1)
    return (jax.nn.silu(a) * b) @ w_down


def causal_pool_minus_self(u, window):
    b, s, c = u.shape
    uf = u.astype(jnp.float32)
    cs = jnp.cumsum(uf, axis=1)
    cs_pad = jnp.concatenate([jnp.zeros((b, 1, c), jnp.float32), cs], axis=1)
    prev = jnp.concatenate([jnp.zeros((b, window - 1, c), jnp.float32), cs_pad[:, : s - window + 1]], axis=1)
    count = jnp.minimum(jnp.arange(1, s + 1, dtype=jnp.float32), float(window))[None, :, None]
    return ((cs - prev) / count - uf).astype(u.dtype)


def pool_mixer(u, w_grp, b_grp, scale):
    b, s, _ = u.shape
    ug = u.reshape(b, s, POOL_GROUPS, POOL_GROUP_DIM)
    pooled = jnp.stack([causal_pool_minus_self(ug[:, :, g], POOL_WINDOWS[g]) for g in range(POOL_GROUPS)], axis=2)
    mixed = jnp.einsum('bsgc,gcd->bsgd', pooled, w_grp) + b_grp
    return mixed.reshape(b, s, POOL_WIDTH) * scale


def causal_depthwise_conv(u, w, bias):
    s = u.shape[1]
    up = jnp.pad(u, ((0, 0), (CONV_WIDTH - 1, 0), (0, 0)))
    y = sum(up[:, k:k + s] * w[k] for k in range(CONV_WIDTH))
    return y + bias


def _lru_combine(left, right):
    a_l, b_l = left
    a_r, b_r = right
    return a_l * a_r, a_r * b_l + b_r


def rg_lru(u, w_a, b_a, w_x, b_x, lam):
    b, s, _ = u.shape
    uh = u.reshape(b, s, LRU_HEADS, LRU_HEAD_DIM)
    r = jax.nn.sigmoid(jnp.einsum('bshd,hde->bshe', uh, w_a) + b_a).reshape(b, s, LRU_WIDTH)
    i = jax.nn.sigmoid(jnp.einsum('bshd,hde->bshe', uh, w_x) + b_x).reshape(b, s, LRU_WIDTH)
    log_a = -LRU_C * r.astype(jnp.float32) * jax.nn.softplus(-lam.astype(jnp.float32))
    a = jnp.exp(log_a)
    mult = jnp.sqrt(-jnp.expm1(2.0 * log_a))
    bx = mult * (i * u).astype(jnp.float32)
    _, h = lax.associative_scan(_lru_combine, (a, bx), axis=1)
    return h.astype(u.dtype)


def hybrid_mixer(h, w_in, pool_w, pool_b, pool_scale, w_pool_up, conv_w, conv_b,
                 lru_w_a, lru_b_a, lru_w_x, lru_b_x, lru_lambda, w_lru_up, w_out):
    proj = h @ w_in
    s1 = POOL_WIDTH
    s2 = s1 + LRU_WIDTH
    s3 = s2 + LRU_WIDTH
    u_pool, u_lru, u_gelu, g_logits = proj[..., :s1], proj[..., s1:s2], proj[..., s2:s3], proj[..., s3:]
    y_pool = pool_mixer(u_pool, pool_w, pool_b, pool_scale) @ w_pool_up
    v = causal_depthwise_conv(u_lru, conv_w, conv_b)
    y_lru = (rg_lru(v, lru_w_a, lru_b_a, lru_w_x, lru_b_x, lru_lambda) * jax.nn.gelu(u_gelu)) @ w_lru_up
    g = jax.nn.sigmoid(g_logits)
    g_pool, g_lru = g[..., :D_MODEL], g[..., D_MODEL:]
    return (g_pool * y_pool + g_lru * y_lru) @ w_out


def setup_inputs(seed: int = 0) -> dict:
    key = jax.random.key(seed)
    ks = jax.random.split(key, 26)
    f32 = jnp.float32

    def nrm(k, shape, fan_in):
        return jax.random.normal(k, shape, f32) * (fan_in ** -0.5)

    def gain(k, shape):
        return 1.0 + 0.02 * jax.random.normal(k, shape, f32)

    def small(k, shape):
        return 0.01 * jax.random.normal(k, shape, f32)

    L = DEPTH
    a_c = jax.random.uniform(ks[17], (L, LRU_WIDTH), f32, 0.9, 0.999)
    sig = a_c ** (1.0 / LRU_C)
    lam = jnp.log(sig) - jnp.log1p(-sig)
    return {
        "x": jax.random.normal(ks[0], (BATCH, SEQ, D_MODEL), f32),
        "norm_ffn1": gain(ks[1], (L, D_MODEL)),
        "ffn1_w_up": nrm(ks[2], (L, D_MODEL, 2 * D_FF), D_MODEL),
        "ffn1_w_down": nrm(ks[3], (L, D_FF, D_MODEL), D_FF),
        "norm_mix": gain(ks[4], (L, D_MODEL)),
        "w_in": nrm(ks[5], (L, D_MODEL, IN_WIDTH), D_MODEL),
        "pool_w": nrm(ks[6], (L, POOL_GROUPS, POOL_GROUP_DIM, POOL_GROUP_DIM), POOL_GROUP_DIM),
        "pool_b": small(ks[7], (L, POOL_GROUPS, POOL_GROUP_DIM)),
        "pool_scale": 1.0 + 0.1 * jax.random.normal(ks[8], (L, POOL_WIDTH), f32),
        "w_pool_up": nrm(ks[9], (L, POOL_WIDTH, D_MODEL), POOL_WIDTH),
        "conv_w": nrm(ks[10], (L, CONV_WIDTH, LRU_WIDTH), CONV_WIDTH),
        "conv_b": small(ks[11], (L, LRU_WIDTH)),
        "lru_w_a": nrm(ks[12], (L, LRU_HEADS, LRU_HEAD_DIM, LRU_HEAD_DIM), LRU_HEAD_DIM),
        "lru_b_a": small(ks[13], (L, LRU_HEADS, LRU_HEAD_DIM)),
        "lru_w_x": nrm(ks[14], (L, LRU_HEADS, LRU_HEAD_DIM, LRU_HEAD_DIM), LRU_HEAD_DIM),
        "lru_b_x": small(ks[15], (L, LRU_HEADS, LRU_HEAD_DIM)),
        "lru_lambda": lam,
        "w_lru_up": nrm(ks[16], (L, LRU_WIDTH, D_MODEL), LRU_WIDTH),
        "w_out": nrm(ks[18], (L, D_MODEL, D_MODEL), D_MODEL),
        "norm_ffn2": gain(ks[19], (L, D_MODEL)),
        "ffn2_w_up": nrm(ks[20], (L, D_MODEL, 2 * D_FF), D_MODEL),
        "ffn2_w_down": nrm(ks[21], (L, D_FF, D_MODEL), D_FF),
        "final_norm": gain(ks[22], (D_MODEL,)),
    }


def reference(x, norm_ffn1, ffn1_w_up, ffn1_w_down, norm_mix, w_in, pool_w, pool_b, pool_scale,
              w_pool_up, conv_w, conv_b, lru_w_a, lru_b_a, lru_w_x, lru_b_x, lru_lambda, w_lru_up,
              w_out, norm_ffn2, ffn2_w_up, ffn2_w_down, final_norm):
    for l in range(DEPTH):
        x = x + 0.5 * swiglu_ffn(rmsnorm(x, norm_ffn1[l]), ffn1_w_up[l], ffn1_w_down[l])
        x = x + hybrid_mixer(rmsnorm(x, norm_mix[l]), w_in[l], pool_w[l], pool_b[l], pool_scale[l],
                             w_pool_up[l], conv_w[l], conv_b[l], lru_w_a[l], lru_b_a[l],
                             lru_w_x[l], lru_b_x[l], lru_lambda[l], w_lru_up[l], w_out[l])
        x = x + 0.5 * swiglu_ffn(rmsnorm(x, norm_ffn2[l]), ffn2_w_up[l], ffn2_w_down[l])
    return rmsnorm(x, final_norm)
```

```cpp
#include <hip/hip_runtime.h>
#include <hip/hip_cooperative_groups.h>
#include <cstdio>
#include <cstdint>
namespace cg = cooperative_groups;
namespace pg8 {
#define PG8_LAS __attribute__((address_space(3)))
typedef unsigned short bf16_t;
typedef short bf16x8 __attribute__((ext_vector_type(8)));
typedef float f32x4 __attribute__((ext_vector_type(4)));
typedef unsigned u32x4 __attribute__((ext_vector_type(4)));
constexpr int BM = 256, BK = 64, HALF = 128, HTB = HALF * BK * 2  , STAGE_BYTES = 8 * HTB, NXCD = 8, WGM = 8;

__host__ __device__ __forceinline__ int lds_byte(int r, int c) { const int st = (r >> 4) * 2 + (c >> 5), rr = r & 15, cc = c & 31, ob = rr * 64 + cc * 2; return st * 1024 + (ob ^ (((ob >> 9) & 1) << 5)); }
__host__ __device__ __forceinline__ void stage_rc(int b, int& R, int& C) { const int st = b / 1024, sb = b % 1024, swz = sb ^ (((sb >> 9) & 1) << 5); R = (st >> 1) * 16 + swz / 64; C = (st & 1) * 32 + (swz % 64) / 2; }
__host__ __device__ __forceinline__ int perm32(int rho) { const int n = rho >> 4, i = rho & 15; return 8 * (i >> 2) + 4 * n + (i & 3); }

struct Unit { int pm, pn; };
struct Gemm { const bf16_t* A; const bf16_t* Bt; int M, N, K; };

struct StaticOrder {
    int nM, nN, nwg, G, c;
    __host__ __device__ void init(int M, int N, int G_, int c_) { nM = M / BM; nN = N / BM; nwg = nM * nN; G = G_; c = c_; }
    __host__ __device__ bool next(int i, Unit& u) const {
        const long L = (long)i * G + c; if (L >= nwg) return false;
        int wgid = (int)L; { const int q = nwg / NXCD, r = nwg % NXCD, xcd = wgid % NXCD, off = wgid / NXCD; wgid = (xcd < r ? xcd * (q + 1) : r * (q + 1) + (xcd - r) * q) + off; }
        const int nig = WGM * nN, gid = wgid / nig, fm = gid * WGM, gsz = (nM - fm) < WGM ? (nM - fm) : WGM;
        u.pm = fm + ((wgid % nig) % gsz); u.pn = (wgid % nig) / gsz; return true;
    }
    __device__ __forceinline__ void a_ready(const Unit&) const {}
    __device__ __forceinline__ void done(const Unit&) const {}
};

template <class Epi, class Sched, bool ALIGN_EPI = false, bool SP2 = false>
__device__ __forceinline__ void gemm_phase(PG8_LAS unsigned char* lds, const Gemm g, const Sched& S, const Epi& E) {
    int tid_l = threadIdx.x; asm volatile("" : "+v"(tid_l));
    const int tid = tid_l, wid = __builtin_amdgcn_readfirstlane(tid >> 6), lane = tid & 63, wr = wid >> 2, wc = wid & 3, fr = lane & 15, fq = lane >> 4;
    const int K = g.K, nt = K / BK;
    unsigned voffA[2], voffB[2];
#pragma unroll
    for (int i = 0; i < 2; ++i) { int R, C; stage_rc(tid * 16 + i * 8192, R, C); const int Rb = Epi::PERM ? ((R & ~31) + perm32(R & 31)) : R;
        voffA[i] = (unsigned)(R * K + C) * 2u; voffB[i] = (unsigned)(Rb * K + C) * 2u; }
    const size_t kstep = (size_t)(BK * 2);
    const size_t hstep = (size_t)HALF * K * 2;
    const size_t tstep = 2 * hstep;
    const unsigned ldsw = (unsigned)wid * 1024u;
    const int aoff = lds_byte(wr * 64 + fr, fq * 8), boff = lds_byte(wc * 32 + fr, fq * 8);
#define PG8_SA(b, h) (((b) * 2 + (h)) * HTB)
#define PG8_SB(b, h) ((4 + (b) * 2 + (h)) * HTB)
#define PG8_STAGE(bufoff, gbase, voff) do { _Pragma("unroll") for (int _i = 0; _i < 2; ++_i) \
        __builtin_amdgcn_global_load_lds((const unsigned*)((const char*)(gbase) + (voff)[_i]), (PG8_LAS unsigned*)(lds + (bufoff) + ldsw + _i * 8192), 16, 0, 0); } while (0)
#define PG8_LDA(dst, b, h) do { _Pragma("unroll") for (int m = 0; m < 4; ++m) _Pragma("unroll") for (int k = 0; k < 2; ++k) dst[m][k] = *(const PG8_LAS bf16x8*)(lds + PG8_SA(b, h) + aoff + m * 2048 + k * 1024); } while (0)
#define PG8_LDB(dst, b, h) do { _Pragma("unroll") for (int n = 0; n < 2; ++n) _Pragma("unroll") for (int k = 0; k < 2; ++k) dst[n][k] = *(const PG8_LAS bf16x8*)(lds + PG8_SB(b, h) + boff + n * 2048 + k * 1024); } while (0)
#define PG8_MMA(ai, bj, At, Bt) do { __builtin_amdgcn_s_setprio(1); _Pragma("unroll") for (int m = 0; m < 4; ++m) _Pragma("unroll") for (int n = 0; n < 2; ++n) _Pragma("unroll") for (int k = 0; k < 2; ++k) \
        acc[ai][bj][m][n] = __builtin_amdgcn_mfma_f32_16x16x32_bf16(Bt[n][k], At[m][k], acc[ai][bj][m][n], 0, 0, 0); __builtin_amdgcn_s_setprio(0); } while (0)
#define PG8_WAIT_V(n) asm volatile("s_waitcnt vmcnt(" #n ")" ::: "memory")
#define PG8_WAIT_L(n) asm volatile("s_waitcnt lgkmcnt(" #n ")" ::: "memory")
#define PG8_BAR __builtin_amdgcn_s_barrier()
#define PG8_SCHED __builtin_amdgcn_sched_barrier(0)
    Unit cur, nxt; int ui = 0;
    if (!S.next(0, cur)) return;
    f32x4 acc[2][2][4][2];
#pragma unroll
    for (int a = 0; a < 2; ++a)
#pragma unroll
        for (int b = 0; b < 2; ++b)
#pragma unroll
            for (int m = 0; m < 4; ++m)
#pragma unroll
                for (int n = 0; n < 2; ++n) acc[a][b][m][n] = (f32x4){0.f, 0.f, 0.f, 0.f};
    bf16x8 At[4][2], B0[2][2], B1[2][2];
    const char* cA = (const char*)g.A + (size_t)cur.pm * tstep; const char* cB = (const char*)g.Bt + (size_t)cur.pn * tstep;
    S.a_ready(cur);
    if constexpr (SP2) {
        PG8_STAGE(PG8_SB(0, 0), cB, voffB); PG8_STAGE(PG8_SB(0, 1), cB + hstep, voffB); PG8_STAGE(PG8_SA(0, 0), cA, voffA); PG8_STAGE(PG8_SA(0, 1), cA + hstep, voffA);
        if (wr == 1) PG8_BAR;
        PG8_WAIT_V(2); PG8_BAR;
        PG8_STAGE(PG8_SB(1, 0), cB + kstep, voffB); PG8_STAGE(PG8_SA(1, 0), cA + kstep, voffA); PG8_STAGE(PG8_SB(1, 1), cB + hstep + kstep, voffB);
        PG8_WAIT_V(6); PG8_BAR;
    } else {
        PG8_STAGE(PG8_SB(0, 0), cB, voffB); PG8_STAGE(PG8_SA(0, 0), cA, voffA); PG8_STAGE(PG8_SB(0, 1), cB + hstep, voffB); PG8_STAGE(PG8_SA(0, 1), cA + hstep, voffA);
        if (wr == 1) PG8_BAR;
        PG8_WAIT_V(4); PG8_BAR;
        PG8_STAGE(PG8_SB(1, 0), cB + kstep, voffB); PG8_STAGE(PG8_SA(1, 0), cA + kstep, voffA); PG8_STAGE(PG8_SB(1, 1), cB + hstep + kstep, voffB);
        PG8_WAIT_V(6); PG8_BAR;
    }
    for (;;) {
        const bool has_next = S.next(ui + 1, nxt);
        const char* nA = has_next ? (const char*)g.A + (size_t)nxt.pm * tstep : cA; const char* nB = has_next ? (const char*)g.Bt + (size_t)nxt.pn * tstep : cB;
        for (int t = 0; t < nt; t += 2) {
            const bool last = (t == nt - 2);
            const char* a1 = cA + (size_t)(t + 1) * kstep;
            const char* a2 = last ? nA : cA + (size_t)(t + 2) * kstep; const char* b2 = last ? nB : cB + (size_t)(t + 2) * kstep;
            const char* a3 = a2 + kstep; const char* b3 = b2 + kstep;
            if (last && has_next) S.a_ready(nxt);
            if constexpr (SP2) {
            PG8_LDB(B0, 0, 0); PG8_LDB(B1, 0, 1); PG8_SCHED; PG8_LDA(At, 0, 0); PG8_STAGE(PG8_SA(1, 1), a1 + hstep, voffA);
            PG8_WAIT_V(8); PG8_WAIT_L(0); PG8_BAR; PG8_MMA(0, 0, At, B0); PG8_MMA(0, 1, At, B1); PG8_BAR; PG8_SCHED;
            PG8_LDA(At, 0, 1); PG8_STAGE(PG8_SB(0, 0), b2, voffB); PG8_STAGE(PG8_SB(0, 1), b2 + hstep, voffB); PG8_STAGE(PG8_SA(0, 0), a2, voffA);
            PG8_WAIT_V(8); PG8_WAIT_L(0); PG8_BAR; PG8_MMA(1, 0, At, B0); PG8_MMA(1, 1, At, B1); PG8_BAR; PG8_SCHED;
            PG8_LDB(B0, 1, 0); PG8_LDB(B1, 1, 1); PG8_SCHED; PG8_LDA(At, 1, 0); PG8_STAGE(PG8_SA(0, 1), a2 + hstep, voffA);
            PG8_WAIT_V(8); PG8_WAIT_L(0); PG8_BAR; PG8_MMA(0, 0, At, B0); PG8_MMA(0, 1, At, B1); PG8_BAR; PG8_SCHED;
            PG8_LDA(At, 1, 1); PG8_STAGE(PG8_SB(1, 0), b3, voffB); PG8_STAGE(PG8_SB(1, 1), b3 + hstep, voffB); PG8_STAGE(PG8_SA(1, 0), a3, voffA);
            PG8_WAIT_V(8); PG8_WAIT_L(0); PG8_BAR; PG8_MMA(1, 0, At, B0); PG8_MMA(1, 1, At, B1); PG8_BAR; PG8_SCHED;
            } else {
            PG8_LDB(B0, 0, 0); PG8_SCHED; PG8_LDA(At, 0, 0); PG8_STAGE(PG8_SA(1, 1), a1 + hstep, voffA);
            PG8_WAIT_L(8); PG8_BAR; PG8_WAIT_L(0); PG8_MMA(0, 0, At, B0); PG8_BAR; PG8_SCHED;
            PG8_LDB(B1, 0, 1); PG8_STAGE(PG8_SB(0, 0), b2, voffB);
            PG8_BAR; PG8_WAIT_L(0); PG8_MMA(0, 1, At, B1); PG8_BAR;
            PG8_LDA(At, 0, 1); PG8_STAGE(PG8_SA(0, 0), a2, voffA);
            PG8_BAR; PG8_WAIT_L(0); PG8_MMA(1, 0, At, B0); PG8_BAR; PG8_SCHED;
            PG8_STAGE(PG8_SB(0, 1), b2 + hstep, voffB);
            PG8_WAIT_V(6); PG8_BAR; PG8_MMA(1, 1, At, B1); PG8_BAR;
            PG8_LDB(B0, 1, 0); PG8_SCHED; PG8_LDA(At, 1, 0); PG8_STAGE(PG8_SA(0, 1), a2 + hstep, voffA);
            PG8_WAIT_L(8); PG8_BAR; PG8_WAIT_L(0); PG8_MMA(0, 0, At, B0); PG8_BAR; PG8_SCHED;
            PG8_LDB(B1, 1, 1); PG8_STAGE(PG8_SB(1, 0), b3, voffB);
            PG8_BAR; PG8_WAIT_L(0); PG8_MMA(0, 1, At, B1); PG8_BAR;
            PG8_LDA(At, 1, 1); PG8_STAGE(PG8_SA(1, 0), a3, voffA);
            PG8_BAR; PG8_WAIT_L(0); PG8_MMA(1, 0, At, B0); PG8_BAR; PG8_SCHED;
            PG8_STAGE(PG8_SB(1, 1), b3 + hstep, voffB);
            PG8_WAIT_V(6); PG8_BAR; PG8_MMA(1, 1, At, B1); PG8_BAR;
            }
        }
        if constexpr (ALIGN_EPI) { if (wr == 0) PG8_BAR; }
        if constexpr (!Epi::AFTER_DRAIN) { E(acc, cur, wr, wc, fr, fq); S.done(cur); }
        if (!has_next) break;
#pragma unroll
        for (int a = 0; a < 2; ++a)
#pragma unroll
            for (int b = 0; b < 2; ++b)
#pragma unroll
                for (int m = 0; m < 4; ++m)
#pragma unroll
                    for (int n = 0; n < 2; ++n) acc[a][b][m][n] = (f32x4){0.f, 0.f, 0.f, 0.f};
        cur = nxt; cA = nA; cB = nB; ++ui;
        if constexpr (ALIGN_EPI) { if (wr == 1) PG8_BAR; }
    }
    PG8_WAIT_V(0);
    if constexpr (!ALIGN_EPI) { if (wr == 0) PG8_BAR; }
    PG8_BAR;
    if constexpr (Epi::AFTER_DRAIN) { E.fused(acc, cur, wr, wc, fr, fq, lds, wid, lane); S.done(cur); }
#undef PG8_SA
#undef PG8_SB
#undef PG8_STAGE
#undef PG8_LDA
#undef PG8_LDB
#undef PG8_MMA
#undef PG8_WAIT_V
#undef PG8_WAIT_L
#undef PG8_BAR
#undef PG8_SCHED
}
}

#define LAS __attribute__((address_space(3)))
typedef unsigned short bf16_t;
using pg8::f32x4; using pg8::u32x4; using pg8::bf16x8; using pg8::Unit;
__device__ __forceinline__ unsigned cvt_pk_bf16(float lo, float hi) { unsigned r; asm volatile("v_cvt_pk_bf16_f32 %0, %1, %2" : "=v"(r) : "v"(lo), "v"(hi)); return r; }
typedef float f32x2 __attribute__((ext_vector_type(2)));
typedef unsigned u32x2 __attribute__((ext_vector_type(2)));

#define XB_TMO      128
#define XB_XCNT(j)  (256  + 64 * (j))
#define XB_XSUB(j)  (1280 + 64 * (j))
#define XB_XGEN(j)  (2304 + 64 * (j))
#define XB_TOP      3328
#define XB_TOPGEN   3392
#define XCD_BAR_WORDS 3456
#define XB_SPIN_CAP (1u << 18)

__device__ __forceinline__ unsigned xb_ld(unsigned* p)              { return __hip_atomic_load(p, __ATOMIC_RELAXED, __HIP_MEMORY_SCOPE_AGENT); }
__device__ __forceinline__ unsigned xb_add(unsigned* p, unsigned v) { return __hip_atomic_fetch_add(p, v, __ATOMIC_RELAXED, __HIP_MEMORY_SCOPE_AGENT); }
__device__ __forceinline__ unsigned xb_xcc_id() { return (unsigned)__builtin_amdgcn_s_getreg((3 << 11) | 20) & 0xFu; }
#define XB_SPIN(cond, bar) do { unsigned _sp = 0; while (cond) { __builtin_amdgcn_s_sleep(1); \
    if ((++_sp & 255u) == 0u) { if (xb_ld(&(bar)[XB_TMO])) break; if (_sp > XB_SPIN_CAP) { atomicAdd(&(bar)[XB_TMO], 1u); break; } } } } while (0)

struct XcdBarrier {
    unsigned* bar; unsigned x;
    volatile LAS unsigned* st;
};

__device__ __forceinline__ XcdBarrier xcd_barrier_post(unsigned* bar, volatile LAS unsigned* st) {
    XcdBarrier b; b.bar = bar; b.x = xb_xcc_id(); b.st = st;
    if (threadIdx.x == 0) (void)xb_add(&bar[XB_XCNT(b.x)], 1u);
    return b;
}
__device__ __forceinline__ void xcd_barrier_complete(unsigned* bar, unsigned x, unsigned& nloc, unsigned& nx) {
    const unsigned G = gridDim.x * gridDim.y * gridDim.z;
    unsigned sum, cnt, mine, sp = 0u;
    for (;;) {
        sum = 0u; cnt = 0u; mine = 0u;
#pragma unroll
        for (unsigned j = 0; j < 16; ++j) { const unsigned c = xb_ld(&bar[XB_XCNT(j)]); sum += c; cnt += (c > 0u) ? 1u : 0u; mine = (j == x) ? c : mine; }
        if (sum == G) break;
        __builtin_amdgcn_s_sleep(1);
        if ((++sp & 255u) == 0u) { if (xb_ld(&bar[XB_TMO])) break; if (sp > XB_SPIN_CAP) { atomicAdd(&bar[XB_TMO], 1u); break; } }
    }
    nloc = mine > 0u ? mine : 1u; nx = cnt > 0u ? cnt : 1u;
}

__device__ __forceinline__ void xcd_barrier(const XcdBarrier& b) {
    asm volatile("s_waitcnt vmcnt(0)" ::: "memory");
    __syncthreads();
    if (threadIdx.x == 0) {
        unsigned* bar = b.bar;
        __builtin_amdgcn_s_waitcnt(0);
        unsigned nloc = b.st[0], nx = b.st[1];
        if (nloc == 0u) { xcd_barrier_complete(bar, b.x, nloc, nx); b.st[0] = nloc; b.st[1] = nx; }
        const unsigned old = xb_add(&bar[XB_XSUB(b.x)], 1u);
        const unsigned gen = old / nloc;
        if (old + 1u == (gen + 1u) * nloc) {
            __builtin_amdgcn_fence(__ATOMIC_RELEASE, "agent");
            asm volatile("s_waitcnt vmcnt(0)" ::: "memory");
            const unsigned og = xb_add(&bar[XB_TOP], 1u);
            const unsigned tg = og / nx;
            if (og + 1u == (tg + 1u) * nx) xb_add(&bar[XB_TOPGEN], 1u);
            else XB_SPIN(xb_ld(&bar[XB_TOPGEN]) == tg, bar);
            __builtin_amdgcn_fence(__ATOMIC_ACQUIRE, "agent");
            xb_add(&bar[XB_XGEN(b.x)], 1u);
            asm volatile("s_waitcnt vmcnt(0)" ::: "memory");
        } else {
            XB_SPIN(xb_ld(&bar[XB_XGEN(b.x)]) == gen, bar);
            __builtin_amdgcn_fence(__ATOMIC_ACQUIRE, "agent");
            asm volatile("s_waitcnt vmcnt(0)" ::: "memory");
        }
    }
    __syncthreads();
}


constexpr int D = 1024, SEQ = 2048, M = 16384, DEPTH = 4;
constexpr int PW = 512, LW = 1280, DFF = 2816, INW = 5120, P1W = 1792, P2W = 3328;
constexpr float EPS = 1e-6f, LOG2E_ = 1.4426950408889634f;
constexpr int NCH = 64, CT = 32;

constexpr size_t OFF_UP1 = 0, OFF_DN1 = OFF_UP1 + (size_t)2 * DFF * D, OFF_WIN = OFF_DN1 + (size_t)D * DFF, OFF_WPU = OFF_WIN + (size_t)INW * D,
                 OFF_WLU = OFF_WPU + (size_t)D * PW, OFF_WOUT = OFF_WLU + (size_t)D * LW, OFF_UP2 = OFF_WOUT + (size_t)D * D, OFF_DN2 = OFF_UP2 + (size_t)2 * DFF * D,
                 OFF_WPOOL = OFF_DN2 + (size_t)D * DFF, OFF_WA = OFF_WPOOL + (size_t)128 * PW, OFF_WX = OFF_WA + (size_t)128 * LW, SLOT_ELEMS = OFF_WX + (size_t)128 * LW;
constexpr size_t WS_W = 0, WS_XB = WS_W + 2 * SLOT_ELEMS * 2, WS_R = WS_XB + (size_t)M * D * 2, WS_MIX = WS_R + (size_t)M * INW * 2, WS_HL = WS_MIX + (size_t)M * PW * 2,
                 WS_MERGED = WS_HL + (size_t)M * LW * 2, WS_SS = WS_MERGED + (size_t)M * D * 2, WS_SUM = WS_SS + (size_t)13 * M * 16 * 4, WS_BAR = WS_SUM + (size_t)8 * NCH * LW * 2 * 4, WS_CNT = WS_BAR + (size_t)XCD_BAR_WORDS * 4, WS_LBAR = WS_CNT + 256, WS_END = WS_LBAR + 2048 * 4;
constexpr int MISC_OFF = 144 * 1024, RS_OFF = MISC_OFF + 1024, LDS_BYTES = RS_OFF + 1024;

struct Args {
    const float *x, *norm_ffn1, *ffn1_w_up, *ffn1_w_down, *norm_mix, *w_in, *pool_w, *pool_b, *pool_scale, *w_pool_up, *conv_w, *conv_b, *lru_w_a, *lru_b_a, *lru_w_x, *lru_b_x,
                *lru_lambda, *w_lru_up, *w_out, *norm_ffn2, *ffn2_w_up, *ffn2_w_down, *final_norm;
    float* out; unsigned char* ws;
};

__device__ __forceinline__ float bflo(unsigned w) { return __uint_as_float(w << 16); }
__device__ __forceinline__ float bfhi(unsigned w) { return __uint_as_float(w & 0xffff0000u); }
__device__ __forceinline__ float fsig(float v) { return __builtin_amdgcn_rcpf(1.0f + __expf(-v)); }
__device__ __forceinline__ float wave_sum(float v) {
#pragma unroll
    for (int o = 1; o < 64; o <<= 1) v += __shfl_xor(v, o);
    return v;
}
__device__ __forceinline__ float row_rstd(const float* ss, int row) {
    const f32x4* q = (const f32x4*)(ss + (size_t)row * 16); const f32x4 s4 = (q[0] + q[1]) + (q[2] + q[3]);
    return rsqrtf(((s4[0] + s4[1]) + (s4[2] + s4[3])) * (1.0f / D) + EPS);
}
__device__ __forceinline__ u32x4 pack8(const f32x4 a, const f32x4 b) { u32x4 w; w.x = cvt_pk_bf16(a[0], a[1]); w.y = cvt_pk_bf16(a[2], a[3]); w.z = cvt_pk_bf16(b[0], b[1]); w.w = cvt_pk_bf16(b[2], b[3]); return w; }

struct EpiSwiglu {
    static constexpr bool PERM = true, AFTER_DRAIN = false;
    bf16_t* O; const float* ss; const LAS float* RS; int pm0;
    __device__ __forceinline__ void operator()(const f32x4 (&acc)[2][2][4][2], const Unit& u, int wr, int wc, int fr, int fq) const {
        const int row0 = u.pm * 256 + wr * 64 + fr, col0 = u.pn * 128 + wc * 32 + 8 * fq;
#pragma unroll
        for (int ai = 0; ai < 2; ++ai)
#pragma unroll
            for (int m = 0; m < 4; ++m) {
                const int row = row0 + ai * 128 + m * 16; const float rs = (u.pm == pm0) ? RS[row & 255] : row_rstd(ss, row), rsl = -LOG2E_ * rs, rs2 = rs * rs;
                f32x4 t[2], q[2], e[2];
#pragma unroll
                for (int n = 0; n < 2; ++n) { t[n] = acc[ai][0][m][n] * rsl; q[n] = acc[ai][0][m][n] * acc[ai][1][m][n]; }
#pragma unroll
                for (int n = 0; n < 2; ++n)
#pragma unroll
                    for (int j = 0; j < 4; ++j) e[n][j] = __builtin_amdgcn_exp2f(t[n][j]);
#pragma unroll
                for (int n = 0; n < 2; ++n) { e[n] = e[n] + 1.0f; q[n] = q[n] * rs2; }
#pragma unroll
                for (int n = 0; n < 2; ++n)
#pragma unroll
                    for (int j = 0; j < 4; ++j) e[n][j] = __builtin_amdgcn_rcpf(e[n][j]);
                __builtin_nontemporal_store(pack8(q[0] * e[0], q[1] * e[1]), (u32x4*)(O + (size_t)row * DFF + col0));
            }
    }
};
struct EpiProj {
    static constexpr bool PERM = true, AFTER_DRAIN = false;
    bf16_t* P1; bf16_t* P2; const float* ss; const LAS float* RS; int pm0;
    __device__ __forceinline__ void operator()(const f32x4 (&acc)[2][2][4][2], const Unit& u, int wr, int wc, int fr, int fq) const {
        const int row0 = u.pm * 256 + wr * 64 + fr; const int kind = u.pn < 7 ? 0 : (u.pn < 12 ? 1 : 2);
        bf16_t* base = kind == 0 ? P1 : P2; const int ld = kind == 0 ? P1W : P2W; const int col0 = (kind == 0 ? u.pn : u.pn - 7) * 256 + wc * 32 + 8 * fq;
        const float c3 = kind == 1 ? -LOG2E_ * 1.5957691216f * 0.044715f : 0.f, c1 = kind == 1 ? -LOG2E_ * 1.5957691216f : -LOG2E_;
#pragma unroll
        for (int ai = 0; ai < 2; ++ai)
#pragma unroll
            for (int m = 0; m < 4; ++m) {
                const int row = row0 + ai * 128 + m * 16; const float rs = (u.pm == pm0) ? RS[row & 255] : row_rstd(ss, row);
#pragma unroll
                for (int bj = 0; bj < 2; ++bj) {
                    f32x4 v[2], e[2];
#pragma unroll
                    for (int n = 0; n < 2; ++n) { v[n] = acc[ai][bj][m][n] * rs; e[n] = v[n] * ((v[n] * v[n]) * c3 + c1); }
                    if (kind != 0) {
#pragma unroll
                        for (int n = 0; n < 2; ++n)
#pragma unroll
                            for (int j = 0; j < 4; ++j) e[n][j] = __builtin_amdgcn_exp2f(e[n][j]);
#pragma unroll
                        for (int n = 0; n < 2; ++n) e[n] = e[n] + 1.0f;
#pragma unroll
                        for (int n = 0; n < 2; ++n)
#pragma unroll
                            for (int j = 0; j < 4; ++j) e[n][j] = __builtin_amdgcn_rcpf(e[n][j]);
                        if (kind == 1) { v[0] = v[0] * e[0]; v[1] = v[1] * e[1]; } else { v[0] = e[0]; v[1] = e[1]; }
                    }
                    __builtin_nontemporal_store(pack8(v[0], v[1]), (u32x4*)(base + (size_t)row * ld + col0 + bj * 128));
                }
            }
    }
};
struct EpiResid {
    static constexpr bool PERM = true, AFTER_DRAIN = false;
    bf16_t* xb; float* ssn; float scale;
    __device__ __forceinline__ void operator()(const f32x4 (&acc)[2][2][4][2], const Unit& u, int wr, int wc, int fr, int fq) const {
        const int row0 = u.pm * 256 + wr * 64 + fr, col0 = u.pn * 256 + wc * 32 + 8 * fq;
#pragma unroll
        for (int ai = 0; ai < 2; ++ai)
#pragma unroll
            for (int m = 0; m < 4; ++m) {
                const int row = row0 + ai * 128 + m * 16; float p = 0.f;
#pragma unroll
                for (int bj = 0; bj < 2; ++bj) {
                    const size_t off = (size_t)row * D + col0 + bj * 128;
                    const u32x4 xx = *(const u32x4*)(xb + off);
                    const f32x4 x0 = (f32x4){bflo(xx.x), bfhi(xx.x), bflo(xx.y), bfhi(xx.y)}, x1 = (f32x4){bflo(xx.z), bfhi(xx.z), bflo(xx.w), bfhi(xx.w)};
                    const f32x4 y0 = x0 + acc[ai][bj][m][0] * scale, y1 = x1 + acc[ai][bj][m][1] * scale;
                    *(u32x4*)(xb + off) = pack8(y0, y1);
                    const f32x4 q = y0 * y0 + y1 * y1; p += (q[0] + q[1]) + (q[2] + q[3]);
                }
                p += __shfl_xor(p, 16); p += __shfl_xor(p, 32);
                if (fq == 0) ssn[(size_t)row * 16 + u.pn * 4 + wc] = p;
            }
    }
};
struct EpiGateA {
    static constexpr bool PERM = true, AFTER_DRAIN = false;
    bf16_t* T; const bf16_t* G;
    __device__ __forceinline__ void operator()(const f32x4 (&acc)[2][2][4][2], const Unit& u, int wr, int wc, int fr, int fq) const {
        const int row0 = u.pm * 256 + wr * 64 + fr, col0 = u.pn * 256 + wc * 32 + 8 * fq;
#pragma unroll
        for (int ai = 0; ai < 2; ++ai)
#pragma unroll
            for (int m = 0; m < 4; ++m) {
                const int row = row0 + ai * 128 + m * 16;
#pragma unroll
                for (int bj = 0; bj < 2; ++bj) {
                    const int c = col0 + bj * 128;
                    const u32x4 g = *(const u32x4*)(G + (size_t)row * P2W + c);
                    f32x4 o0 = acc[ai][bj][m][0], o1 = acc[ai][bj][m][1];
                    o0[0] *= bflo(g.x); o0[1] *= bfhi(g.x); o0[2] *= bflo(g.y); o0[3] *= bfhi(g.y); o1[0] *= bflo(g.z); o1[1] *= bfhi(g.z); o1[2] *= bflo(g.w); o1[3] *= bfhi(g.w);
                    *(u32x4*)(T + (size_t)row * D + c) = pack8(o0, o1);
                }
            }
    }
};
struct EpiGateB {
    static constexpr bool PERM = true, AFTER_DRAIN = false;
    bf16_t* O; const bf16_t* T; const bf16_t* G;
    __device__ __forceinline__ void operator()(const f32x4 (&acc)[2][2][4][2], const Unit& u, int wr, int wc, int fr, int fq) const {
        const int row0 = u.pm * 256 + wr * 64 + fr, col0 = u.pn * 256 + wc * 32 + 8 * fq;
#pragma unroll
        for (int ai = 0; ai < 2; ++ai)
#pragma unroll
            for (int m = 0; m < 4; ++m) {
                const int row = row0 + ai * 128 + m * 16;
#pragma unroll
                for (int bj = 0; bj < 2; ++bj) {
                    const int c = col0 + bj * 128;
                    const u32x4 g = *(const u32x4*)(G + (size_t)row * P2W + c);
                    const u32x4 t = *(const u32x4*)(T + (size_t)row * D + c);
                    f32x4 o0 = acc[ai][bj][m][0], o1 = acc[ai][bj][m][1];
                    o0[0] = o0[0] * bflo(g.x) + bflo(t.x); o0[1] = o0[1] * bfhi(g.x) + bfhi(t.x); o0[2] = o0[2] * bflo(g.y) + bflo(t.y); o0[3] = o0[3] * bfhi(g.y) + bfhi(t.y);
                    o1[0] = o1[0] * bflo(g.z) + bflo(t.z); o1[1] = o1[1] * bfhi(g.z) + bfhi(t.z); o1[2] = o1[2] * bflo(g.w) + bflo(t.w); o1[3] = o1[3] * bfhi(g.w) + bfhi(t.w);
                    *(u32x4*)(O + (size_t)row * D + c) = pack8(o0, o1);
                }
            }
    }
};

#ifndef GEMM_ALIGN
#define GEMM_ALIGN true
#endif
template <class Epi> __device__ __forceinline__ void run_gemm(LAS unsigned char* lds, const bf16_t* A, const bf16_t* Bt, int N, int K, const Epi& E) {
    pg8::Gemm g{A, Bt, M, N, K}; pg8::StaticOrder S; S.init(M, N, (int)gridDim.x, __builtin_amdgcn_readfirstlane(((volatile LAS int*)(lds + MISC_OFF))[6]));
    pg8::gemm_phase<Epi, pg8::StaticOrder, GEMM_ALIGN, true>(lds, g, S, E);
}

__device__ __forceinline__ int stage_rstd(LAS unsigned char* lds, const float* ss, int N) {
    pg8::StaticOrder S; S.init(M, N, (int)gridDim.x, __builtin_amdgcn_readfirstlane(((volatile LAS int*)(lds + MISC_OFF))[6]));
    pg8::Unit u; int pm0 = -1; if (S.next(0, u)) pm0 = u.pm;
    int tid_l = threadIdx.x; asm volatile("" : "+v"(tid_l));
    if (pm0 >= 0 && tid_l < 256) ((LAS float*)(lds + RS_OFF))[tid_l] = row_rstd(ss, pm0 * 256 + tid_l);
    __syncthreads();
    return pm0;
}

__device__ __forceinline__ void tr_item32(const float* W, int K, int N, bf16_t* WT, const float* gsc, bool swz, LAS float* scr, int item, int lane) {
    const int nblk = N / 64, kb = item / nblk, nb = item - kb * nblk, k0 = 32 * kb, n0 = 64 * nb;
    int rbase = n0;
    if (swz) { const int half = n0 >= DFF ? 1 : 0, hid = n0 - half * DFF; rbase = 256 * (hid >> 7) + 128 * half + (hid & 127); }
    const int kr = lane >> 3, n4 = lane & 7;
    f32x4 v[2][4];
#pragma unroll
    for (int hf = 0; hf < 2; ++hf)
#pragma unroll
        for (int i = 0; i < 4; ++i) v[hf][i] = *(const f32x4*)(W + (size_t)(k0 + kr + 8 * i) * N + n0 + 32 * hf + 4 * n4);
    if (gsc) {
#pragma unroll
        for (int i = 0; i < 4; ++i) { const float gg = gsc[k0 + kr + 8 * i]; v[0][i] = v[0][i] * gg; v[1][i] = v[1][i] * gg; }
    }
    const int c = lane & 3;
#pragma unroll
    for (int hf = 0; hf < 2; ++hf) {
#pragma unroll
        for (int i = 0; i < 4; ++i)
#pragma unroll
            for (int e = 0; e < 4; ++e) scr[(kr + 8 * i) * 33 + 4 * n4 + e] = v[hf][i][e];
        asm volatile("s_waitcnt lgkmcnt(0)" ::: "memory");
#pragma unroll
        for (int j = 0; j < 2; ++j) { const int n = (lane >> 2) + 16 * j; const LAS float* sp = scr + (8 * c) * 33 + n;
            u32x4 o; o.x = cvt_pk_bf16(sp[0 * 33], sp[1 * 33]); o.y = cvt_pk_bf16(sp[2 * 33], sp[3 * 33]); o.z = cvt_pk_bf16(sp[4 * 33], sp[5 * 33]); o.w = cvt_pk_bf16(sp[6 * 33], sp[7 * 33]);
            *(u32x4*)(WT + (size_t)(rbase + 32 * hf + n) * K + k0 + 8 * c) = o; }
        asm volatile("s_waitcnt lgkmcnt(0)" ::: "memory");
    }
}
constexpr int J_UP = (D / 32) * (2 * DFF / 64), J_DN = (DFF / 32) * (D / 64), J_IN = (D / 32) * (INW / 64), J_PU = (PW / 32) * (D / 64), J_LU = (LW / 32) * (D / 64), J_OUT = (D / 32) * (D / 64),
              J_PL = (PW / 32) * (128 / 64), J_WA = (LW / 32) * (128 / 64), J_LAYER = 2 * J_UP + 2 * J_DN + J_IN + J_PU + J_LU + J_OUT + J_PL + 2 * J_WA;
__device__ __forceinline__ void convert_item(const Args& a, int l, bf16_t* slot, LAS float* scr, int it, int lane) {
    int r = it; const float* W; int K, N; bf16_t* WT; const float* g = nullptr; bool swz = false;
    if (r < J_UP) { W = a.ffn1_w_up + (size_t)l * D * 2 * DFF; K = D; N = 2 * DFF; WT = slot + OFF_UP1; g = a.norm_ffn1 + l * D; swz = true; }
    else if ((r -= J_UP) < J_DN) { W = a.ffn1_w_down + (size_t)l * DFF * D; K = DFF; N = D; WT = slot + OFF_DN1; }
    else if ((r -= J_DN) < J_IN) { W = a.w_in + (size_t)l * D * INW; K = D; N = INW; WT = slot + OFF_WIN; g = a.norm_mix + l * D; }
    else if ((r -= J_IN) < J_PU) { W = a.w_pool_up + (size_t)l * PW * D; K = PW; N = D; WT = slot + OFF_WPU; }
    else if ((r -= J_PU) < J_LU) { W = a.w_lru_up + (size_t)l * LW * D; K = LW; N = D; WT = slot + OFF_WLU; }
    else if ((r -= J_LU) < J_OUT) { W = a.w_out + (size_t)l * D * D; K = D; N = D; WT = slot + OFF_WOUT; }
    else if ((r -= J_OUT) < J_UP) { W = a.ffn2_w_up + (size_t)l * D * 2 * DFF; K = D; N = 2 * DFF; WT = slot + OFF_UP2; g = a.norm_ffn2 + l * D; swz = true; }
    else if ((r -= J_UP) < J_DN) { W = a.ffn2_w_down + (size_t)l * DFF * D; K = DFF; N = D; WT = slot + OFF_DN2; }
    else if ((r -= J_DN) < J_PL) { W = a.pool_w + (size_t)l * PW * 128; K = PW; N = 128; WT = slot + OFF_WPOOL; }
    else if ((r -= J_PL) < J_WA) { W = a.lru_w_a + (size_t)l * LW * 128; K = LW; N = 128; WT = slot + OFF_WA; }
    else { r -= J_WA; W = a.lru_w_x + (size_t)l * LW * 128; K = LW; N = 128; WT = slot + OFF_WX; }
    tr_item32(W, K, N, WT, g, swz, scr, r, lane);
}
__device__ __forceinline__ void convert_layer(const Args& a, int l, bf16_t* slot, LAS float* scr, int gw, int NGW, int lane) {
    for (int it = gw; it < J_LAYER; it += NGW) convert_item(a, l, slot, scr, it, lane);
}
__device__ __forceinline__ void convert_dynamic(const Args& a, int l, bf16_t* slot, LAS float* scr, unsigned* counter, int lane) {
    for (;;) {
        unsigned it = 0u; if (lane == 0) it = __hip_atomic_fetch_add(counter, 4u, __ATOMIC_RELAXED, __HIP_MEMORY_SCOPE_AGENT);
        it = (unsigned)__builtin_amdgcn_readfirstlane((int)it);
        if (it >= (unsigned)J_LAYER) break;
        for (unsigned u = 0; u < 4u && it + u < (unsigned)J_LAYER; ++u) convert_item(a, l, slot, scr, (int)(it + u), lane);
    }
}

constexpr int WROW = 272, WA_OFF = 0, WX_OFF = 128 * WROW, WP_OFF = 2 * 128 * WROW, CP_OFF = 3 * 128 * WROW, VW_OFF = CP_OFF + 4096, VW_BYTES = 16 * WROW;
static_assert(VW_BYTES >= 32 * 33 * 4 && VW_OFF + 8 * VW_BYTES <= MISC_OFF, "LDS map");
constexpr float LOG2E = 1.4426950408889634f;
struct MixP {
    const bf16_t *P1, *P2, *Wpool, *Wa, *Wx; bf16_t *mixed, *hl; float* summ;
    const float *pool_b, *pool_scale, *conv_w, *conv_b, *b_a, *b_x, *lam;
};
__device__ __forceinline__ float fsig2(float x) { return __builtin_amdgcn_rcpf(1.0f + __builtin_amdgcn_exp2f(-LOG2E * x)); }

__device__ __forceinline__ void stage_w(LAS unsigned char* lds, int off, const bf16_t* Wt, int ldk, int kofs, int tid) {
#pragma unroll 1
    for (int i = 0; i < 4; ++i) { const int idx = tid + 512 * i, row = idx >> 4, c16 = idx & 15;
        *(LAS u32x4*)(lds + off + row * WROW + c16 * 16) = *(const u32x4*)(Wt + (size_t)row * ldk + kofs + c16 * 8); }
}

template <int PASS> __device__ __forceinline__ void lru_wave_item(LAS unsigned char* lds, LAS unsigned char* vw, int b, int c, int h, const MixP& p, int lane, float (&Hrun)[8], bool cont) {
    const int fr = lane & 15, fq = lane >> 4, cg = fr;
    const LAS float* CP = (const LAS float*)(lds + CP_OFF);
    const int row0 = b * SEQ + c * CT;
    f32x2 wv[4][4], bv[4];
#pragma unroll
    for (int k = 0; k < 4; ++k) { const f32x4 w0 = *(const LAS f32x4*)(CP + k * 128 + cg * 8), w1 = *(const LAS f32x4*)(CP + k * 128 + cg * 8 + 4);
        wv[k][0] = (f32x2){w0[0], w0[1]}; wv[k][1] = (f32x2){w0[2], w0[3]}; wv[k][2] = (f32x2){w1[0], w1[1]}; wv[k][3] = (f32x2){w1[2], w1[3]}; }
    { const f32x4 b0 = *(const LAS f32x4*)(CP + 4 * 128 + cg * 8), b1 = *(const LAS f32x4*)(CP + 4 * 128 + cg * 8 + 4);
      bv[0] = (f32x2){b0[0], b0[1]}; bv[1] = (f32x2){b0[2], b0[3]}; bv[2] = (f32x2){b1[0], b1[1]}; bv[3] = (f32x2){b1[2], b1[3]}; }
    bf16x8 idf[2];
#pragma unroll
    for (int e = 0; e < 2; ++e)
#pragma unroll
        for (int i = 0; i < 8; ++i) idf[e][i] = (16 * e + fr - 8 * fq == i) ? (short)0x3F80 : (short)0;
    float pba[8], pbx[8], pk8[8], Arun[8];
#pragma unroll
    for (int n = 0; n < 8; ++n) { pba[n] = CP[5 * 128 + 16 * n + fr]; pbx[n] = CP[6 * 128 + 16 * n + fr]; pk8[n] = CP[7 * 128 + 16 * n + fr]; Arun[n] = 1.f; if (PASS == 1 || !cont) Hrun[n] = 0.f; }
    if (PASS == 2 && !cont) {
        float h0 = 0.f, h1 = 0.f; const float* sp = p.summ + ((size_t)b * NCH * LW + h * 128 + 32 * fq + fr) * 2;
        for (int cc0 = 0; cc0 < c; cc0 += 8) {
            f32x2 sa[8], sb[8];
#pragma unroll
            for (int u = 0; u < 8; ++u) { const int cc = min(cc0 + u, c - 1); sa[u] = *(const f32x2*)(sp + (size_t)cc * LW * 2); sb[u] = *(const f32x2*)(sp + (size_t)cc * LW * 2 + 32); }
#pragma unroll
            for (int u = 0; u < 8; ++u) if (cc0 + u < c) { h0 = sa[u].x * h0 + sa[u].y; h1 = sb[u].x * h1 + sb[u].y; }
        }
#pragma unroll
        for (int n = 0; n < 8; ++n) Hrun[n] = __shfl((n & 1) ? h1 : h0, fr + 16 * (n >> 1));
    }
    const bf16_t* ub = p.P1 + (size_t)(b * SEQ) * P1W + PW + h * 128 + cg * 8;
#pragma unroll 1
    for (int st = 0; st < CT / 16; ++st) {
        const int s0 = c * CT + 16 * st;
        u32x4 ur[7];
        {
            const int sb = s0 + 4 * fq - 3;
#pragma unroll
            for (int r = 0; r < 7; ++r) ur[r] = *(const u32x4*)(ub + (size_t)max(sb + r, 0) * P1W);
        }
        if (s0 == 0 && fq == 0) {
#pragma unroll
            for (int r = 0; r < 3; ++r) ur[r] = (u32x4){0u, 0u, 0u, 0u};
        }
#pragma unroll
        for (int jj = 0; jj < 4; ++jj) {
            f32x2 o[4] = {bv[0], bv[1], bv[2], bv[3]};
#pragma unroll
            for (int k = 0; k < 4; ++k) { const u32x4 uk = ur[jj + k];
                o[0] = wv[k][0] * (f32x2){bflo(uk.x), bfhi(uk.x)} + o[0]; o[1] = wv[k][1] * (f32x2){bflo(uk.y), bfhi(uk.y)} + o[1];
                o[2] = wv[k][2] * (f32x2){bflo(uk.z), bfhi(uk.z)} + o[2]; o[3] = wv[k][3] * (f32x2){bflo(uk.w), bfhi(uk.w)} + o[3]; }
            { u32x4 w; w.x = cvt_pk_bf16(o[0].x, o[0].y); w.y = cvt_pk_bf16(o[1].x, o[1].y); w.z = cvt_pk_bf16(o[2].x, o[2].y); w.w = cvt_pk_bf16(o[3].x, o[3].y);
              *(LAS u32x4*)(vw + (4 * fq + jj) * WROW + cg * 16) = w; }
        }

        f32x4 aR[8], aI[8];
        bf16x8 af[4];
        {
#pragma unroll
            for (int kk = 0; kk < 4; ++kk) af[kk] = *(const LAS bf16x8*)(vw + fr * WROW + kk * 64 + fq * 16);
#pragma unroll
            for (int n = 0; n < 8; ++n) {
                aR[n] = (f32x4){0.f, 0.f, 0.f, 0.f}; aI[n] = (f32x4){0.f, 0.f, 0.f, 0.f};
#pragma unroll
                for (int kk = 0; kk < 4; ++kk) {
                    const bf16x8 ba = *(const LAS bf16x8*)(lds + WA_OFF + (16 * n + fr) * WROW + kk * 64 + fq * 16);
                    const bf16x8 bx = *(const LAS bf16x8*)(lds + WX_OFF + (16 * n + fr) * WROW + kk * 64 + fq * 16);
                    aR[n] = __builtin_amdgcn_mfma_f32_16x16x32_bf16(af[kk], ba, aR[n], 0, 0, 0);
                    aI[n] = __builtin_amdgcn_mfma_f32_16x16x32_bf16(af[kk], bx, aI[n], 0, 0, 0);
                }
            }
        }
#pragma unroll
        for (int n = 0; n < 8; ++n) {
            const f32x4 aVn = __builtin_amdgcn_mfma_f32_16x16x32_bf16(af[n >> 1], idf[n & 1], (f32x4){0.f, 0.f, 0.f, 0.f}, 0, 0, 0);
            float av[4], bxv[4];
#pragma unroll
            for (int j = 0; j < 4; ++j) {
                const float r = fsig2(aR[n][j] + pba[n]), ig = fsig2(aI[n][j] + pbx[n]);
                const float a = __builtin_amdgcn_exp2f(r * pk8[n]), mult = __builtin_amdgcn_sqrtf(fmaxf(1.0f - a * a, 0.f));
                av[j] = a; bxv[j] = mult * ig * aVn[j];
            }
            const float H0 = bxv[0], H1 = av[1] * H0 + bxv[1], H2 = av[2] * H1 + bxv[2], H3 = av[3] * H2 + bxv[3];
            const float A0 = av[0], A1 = av[1] * A0, A2 = av[2] * A1, A3 = av[3] * A2;
            float At[4], Ht[4];
#pragma unroll
            for (int q = 0; q < 4; ++q) { At[q] = __shfl(A3, fr + 16 * q); Ht[q] = __shfl(H3, fr + 16 * q); }
            const float c0 = Hrun[n], c1 = At[0] * c0 + Ht[0], c2 = At[1] * c1 + Ht[1], c3 = At[2] * c2 + Ht[2], c4 = At[3] * c3 + Ht[3];
            Hrun[n] = c4;
            if (PASS == 1) Arun[n] *= (At[0] * At[1]) * (At[2] * At[3]);
            if (PASS == 2) {
                const float cin = fq == 0 ? c0 : (fq == 1 ? c1 : (fq == 2 ? c2 : c3));
                aR[n][0] = H0 + A0 * cin; aR[n][1] = H1 + A1 * cin; aR[n][2] = H2 + A2 * cin; aR[n][3] = H3 + A3 * cin;
            }
        }
        if (PASS == 2) {
#pragma unroll
            for (int n = 0; n < 8; ++n)
#pragma unroll
                for (int j = 0; j < 4; j += 2) { const unsigned w = cvt_pk_bf16(aR[n][j], aR[n][j + 1]);
                    *(LAS unsigned short*)(vw + (4 * fq + j) * WROW + (16 * n + fr) * 2) = (unsigned short)(w & 0xffffu);
                    *(LAS unsigned short*)(vw + (4 * fq + j + 1) * WROW + (16 * n + fr) * 2) = (unsigned short)(w >> 16); }
#pragma unroll
            for (int i = 0; i < 4; ++i) {
                const int t = fq + 4 * i; const size_t row = (size_t)(row0 + 16 * st + t);
                const u32x4 hh = *(const LAS u32x4*)(vw + t * WROW + cg * 16);
                const u32x4 g = *(const u32x4*)(p.P2 + row * P2W + h * 128 + cg * 8);
                const f32x4 o0 = (f32x4){bflo(hh.x) * bflo(g.x), bfhi(hh.x) * bfhi(g.x), bflo(hh.y) * bflo(g.y), bfhi(hh.y) * bfhi(g.y)};
                const f32x4 o1 = (f32x4){bflo(hh.z) * bflo(g.z), bfhi(hh.z) * bfhi(g.z), bflo(hh.w) * bflo(g.w), bfhi(hh.w) * bfhi(g.w)};
                *(u32x4*)(p.hl + row * LW + h * 128 + cg * 8) = pack8(o0, o1);
            }
        }
    }
    if (PASS == 1 && fq == 0) {
#pragma unroll
        for (int n = 0; n < 8; ++n) *(f32x2*)(p.summ + (((size_t)b * NCH + c) * LW + h * 128 + 16 * n + fr) * 2) = (f32x2){Arun[n], Hrun[n]};
    }
}

__device__ __forceinline__ void pool_items(LAS unsigned char* lds, LAS unsigned char* vw, int g, int wi, int nw, const MixP& p, int lane);
template <int PASS> __device__ __forceinline__ void lru_pass(LAS unsigned char* lds, const MixP& p, const Args& a, int cv_layer, bf16_t* cv_slot, unsigned* cv_counter) {
    int tid_l = threadIdx.x; asm volatile("" : "+v"(tid_l));
    const int tid = tid_l, lane = tid & 63, wave = __builtin_amdgcn_readfirstlane(tid >> 6);
    const int G = (int)gridDim.x, bid = (int)blockIdx.x, HS = G < 10 ? G : 10;
    LAS unsigned char* vw = lds + VW_OFF + wave * VW_BYTES;
    bool first = true;
    for (int h = bid % HS; h < 10; h += HS) {
        const int nblk = G >= 10 ? (G - h + 9) / 10 : 1, wi = (G >= 10 ? bid / 10 : 0) * 8 + wave, nw = nblk * 8;
        stage_w(lds, WA_OFF, p.Wa, LW, h * 128, tid); stage_w(lds, WX_OFF, p.Wx, LW, h * 128, tid);
        if (PASS == 1 && first) stage_w(lds, WP_OFF, p.Wpool, PW, (bid & 3) * 128, tid);
        if (tid < 128) { LAS float* CP = (LAS float*)(lds + CP_OFF); const int gch = h * 128 + tid;
#pragma unroll
            for (int k = 0; k < 4; ++k) CP[k * 128 + tid] = p.conv_w[k * LW + gch];
            CP[4 * 128 + tid] = p.conv_b[gch]; CP[5 * 128 + tid] = p.b_a[gch]; CP[6 * 128 + tid] = p.b_x[gch];
            CP[7 * 128 + tid] = -8.0f * LOG2E * log1pf(expf(-p.lam[gch])); }
        __syncthreads();
        {
            const int NI = 8 * NCH, jlo = (int)((long)wi * NI / nw), jhi = (int)((long)(wi + 1) * NI / nw); float Hrun[8];
            for (int j = jlo; j < jhi; ++j) lru_wave_item<PASS>(lds, vw, j / NCH, j % NCH, h, p, lane, Hrun, j > jlo && (j % NCH) != 0);
        }
        if (PASS == 1 && first) {
            pool_items(lds, vw, bid & 3, (bid >> 2) * 8 + wave, ((G - (bid & 3) + 3) >> 2) * 8, p, lane);
            if (cv_layer >= 0) convert_dynamic(a, cv_layer, cv_slot, (LAS float*)vw, cv_counter, lane);
        }
        first = false;
        __syncthreads();
    }
}

template <int WIN> __device__ __forceinline__ void pool_subtile(LAS unsigned char* vw, const bf16_t* up  , int s0, int lane) {
    const int cg = lane & 15, tq = lane >> 4, sf = s0 + 4 * tq;
    u32x4 rw[WIN + 3];
#pragma unroll
    for (int r = 0; r < WIN + 3; ++r) { const int sp = sf - (WIN - 1) + r; rw[r] = *(const u32x4*)(up + (size_t)max(sp, 0) * P1W); if (sp < 0) rw[r] = (u32x4){0u, 0u, 0u, 0u}; }
    f32x4 s0v = (f32x4){0.f, 0.f, 0.f, 0.f}, s1v = s0v;
#pragma unroll
    for (int r = 0; r < WIN - 1; ++r) { s0v += (f32x4){bflo(rw[r].x), bfhi(rw[r].x), bflo(rw[r].y), bfhi(rw[r].y)}; s1v += (f32x4){bflo(rw[r].z), bfhi(rw[r].z), bflo(rw[r].w), bfhi(rw[r].w)}; }
#pragma unroll
    for (int jj = 0; jj < 4; ++jj) {
        const u32x4 e = rw[jj + WIN - 1]; const f32x4 e0 = (f32x4){bflo(e.x), bfhi(e.x), bflo(e.y), bfhi(e.y)}, e1 = (f32x4){bflo(e.z), bfhi(e.z), bflo(e.w), bfhi(e.w)};
        s0v += e0; s1v += e1;
        const float inv = 1.0f / (float)min(sf + jj + 1, WIN);
        *(LAS u32x4*)(vw + (4 * tq + jj) * WROW + cg * 16) = pack8(s0v * inv - e0, s1v * inv - e1);
        const u32x4 o = rw[jj]; s0v -= (f32x4){bflo(o.x), bfhi(o.x), bflo(o.y), bfhi(o.y)}; s1v -= (f32x4){bflo(o.z), bfhi(o.z), bflo(o.w), bfhi(o.w)};
    }
}
__device__ __forceinline__ void pool_items(LAS unsigned char* lds, LAS unsigned char* vw, int g, int wi, int nw, const MixP& p, int lane) {
    const int fr = lane & 15, fq = lane >> 4, cg = fr;
    float pb[8], ps[8];
#pragma unroll
    for (int n = 0; n < 8; ++n) { pb[n] = p.pool_b[g * 128 + 16 * n + fr]; ps[n] = p.pool_scale[g * 128 + 16 * n + fr]; }
    for (int j = wi; j < 8 * 64; j += nw) {
        const int b = j >> 6, c32 = j & 63; const bf16_t* up = p.P1 + (size_t)(b * SEQ) * P1W + g * 128 + cg * 8;
#pragma unroll 1
        for (int st = 0; st < 2; ++st) {
            const int s0 = c32 * 32 + 16 * st;
            if (g == 0) pool_subtile<2>(vw, up, s0, lane); else if (g == 1) pool_subtile<4>(vw, up, s0, lane); else if (g == 2) pool_subtile<8>(vw, up, s0, lane); else pool_subtile<16>(vw, up, s0, lane);
            bf16x8 af[4];
#pragma unroll
            for (int kk = 0; kk < 4; ++kk) af[kk] = *(const LAS bf16x8*)(vw + fr * WROW + kk * 64 + fq * 16);
            f32x4 acc[8];
#pragma unroll
            for (int n = 0; n < 8; ++n) { acc[n] = (f32x4){0.f, 0.f, 0.f, 0.f};
#pragma unroll
                for (int kk = 0; kk < 4; ++kk) acc[n] = __builtin_amdgcn_mfma_f32_16x16x32_bf16(af[kk], *(const LAS bf16x8*)(lds + WP_OFF + (16 * n + fr) * WROW + kk * 64 + fq * 16), acc[n], 0, 0, 0); }
#pragma unroll
            for (int n = 0; n < 8; ++n)
#pragma unroll
                for (int jj = 0; jj < 4; jj += 2) { const unsigned w = cvt_pk_bf16((acc[n][jj] + pb[n]) * ps[n], (acc[n][jj + 1] + pb[n]) * ps[n]);
                    *(LAS unsigned short*)(vw + (4 * fq + jj) * WROW + (16 * n + fr) * 2) = (unsigned short)(w & 0xffffu);
                    *(LAS unsigned short*)(vw + (4 * fq + jj + 1) * WROW + (16 * n + fr) * 2) = (unsigned short)(w >> 16); }
#pragma unroll
            for (int i = 0; i < 4; ++i) { const int t = fq + 4 * i;
                *(u32x4*)(p.mixed + (size_t)(b * SEQ + s0 + t) * PW + g * 128 + cg * 8) = *(const LAS u32x4*)(vw + t * WROW + cg * 16); }
        }
    }
}

constexpr int N_LRU = 8 * NCH * 10, N_POOL = 8 * NCH * 4;
#ifndef REP_M2
#define REP_M2 0
#endif
#ifndef REP_SYNC
#define REP_SYNC 0
#endif
#ifndef REP_FA
#define REP_FA 0
#endif
#ifndef REP_FB
#define REP_FB 0
#endif
#ifndef REP_CONV
#define REP_CONV 0
#endif
#ifndef REP_M4
#define REP_M4 0
#endif
#ifndef REP_M5
#define REP_M5 0
#endif
#ifndef REP_M1
#define REP_M1 0
#endif
__global__ void __launch_bounds__(512, 2) fwd_mega(Args a) {
    extern __shared__ __attribute__((aligned(16))) unsigned char lds_raw[];
    LAS unsigned char* lds = (LAS unsigned char*)lds_raw;
    cg::grid_group grid = cg::this_grid();
#define GSYNC() do { asm volatile("s_waitcnt vmcnt(0) lgkmcnt(0)" ::: "memory"); grid.sync(); __builtin_amdgcn_fence(__ATOMIC_ACQUIRE, "agent"); asm volatile("s_waitcnt vmcnt(0)" ::: "memory"); } while (0)
#define LANE_IDS() int tid_l = threadIdx.x; asm volatile("" : "+v"(tid_l)); const int tid = tid_l, lane = tid & 63, wave = __builtin_amdgcn_readfirstlane(tid >> 6), gw = blockIdx.x * 8 + wave, NGW = gridDim.x * 8; (void)gw; (void)NGW; (void)lane
    unsigned char* ws = a.ws;
    bf16_t* Wb = (bf16_t*)(ws + WS_W); bf16_t* XB = (bf16_t*)(ws + WS_XB); bf16_t* R = (bf16_t*)(ws + WS_R);
    bf16_t* P1 = R; bf16_t* P2 = R + (size_t)M * P1W; bf16_t* ACT = R; bf16_t* TB = R;
    bf16_t* MIX = (bf16_t*)(ws + WS_MIX); bf16_t* HL = (bf16_t*)(ws + WS_HL); bf16_t* MRG = (bf16_t*)(ws + WS_MERGED);
    float* SS = (float*)(ws + WS_SS); float* SUMM = (float*)(ws + WS_SUM);

    {
    LANE_IDS();
    if (blockIdx.x == 0) for (int i = tid; i < XCD_BAR_WORDS + 64 + 2048; i += 512) ((unsigned*)(ws + WS_BAR))[i] = 0u;
    if (tid < 8) ((volatile LAS unsigned*)(lds + MISC_OFF))[tid] = tid == 6 ? blockIdx.x : 0u;
    __syncthreads();
    GSYNC();
    if (tid == 0) { const unsigned x = xb_xcc_id(); ((volatile LAS unsigned*)(lds + MISC_OFF))[4] = xb_add(&((unsigned*)(ws + WS_BAR))[XB_XCNT(x)], 1u); }
#define XSYNC() do { unsigned long long off_l = WS_BAR; asm volatile("" : "+s"(off_l)); XcdBarrier bb; bb.bar = (unsigned*)(ws + off_l); bb.x = xb_xcc_id(); asm volatile("" : "+s"(bb.x)); bb.st = (volatile LAS unsigned*)(lds + MISC_OFF); xcd_barrier(bb); } while (0)
    convert_layer(a, 0, Wb, (LAS float*)(lds + VW_OFF + wave * VW_BYTES), gw, NGW, lane);
    for (int row0 = gw; row0 < M; row0 += 4 * NGW) {
        f32x4 v[4][4];
#pragma unroll
        for (int u = 0; u < 4; ++u) { const int row = min(row0 + u * NGW, M - 1); const f32x4* xr = (const f32x4*)(a.x + (size_t)row * D) + lane;
#pragma unroll
            for (int j = 0; j < 4; ++j) v[u][j] = xr[64 * j]; }
#pragma unroll
        for (int u = 0; u < 4; ++u) { const int row = row0 + u * NGW; if (row >= M) break; float s = 0.f;
#pragma unroll
            for (int j = 0; j < 4; ++j) { const f32x4 w = v[u][j]; s += (w[0] * w[0] + w[1] * w[1]) + (w[2] * w[2] + w[3] * w[3]);
                u32x2 o; o.x = cvt_pk_bf16(w[0], w[1]); o.y = cvt_pk_bf16(w[2], w[3]); *((u32x2*)(XB + (size_t)row * D) + lane + 64 * j) = o; }
            s = wave_sum(s); if (lane < 16) SS[(size_t)row * 16 + lane] = lane == 0 ? s : 0.f; }
    }
    }
    XSYNC();
    if (threadIdx.x == 0) {
        unsigned* bar = (unsigned*)(ws + WS_BAR); const unsigned per = gridDim.x >> 3; bool ok = (gridDim.x & 7u) == 0u;
        for (unsigned j = 0; j < 16; ++j) { const unsigned cnt = xb_ld(&bar[XB_XCNT(j)]); ok = ok && (j < 8 ? cnt == per : cnt == 0u); }
        volatile LAS unsigned* MISC = (volatile LAS unsigned*)(lds + MISC_OFF);
        MISC[5] = ok ? 1u : 0u; MISC[6] = ok ? xb_xcc_id() + 8u * MISC[4] : blockIdx.x;
    }
    __syncthreads();
    const bool xlocal = __builtin_amdgcn_readfirstlane(((volatile LAS int*)(lds + MISC_OFF))[5]) != 0;
#define XSYNC_L() do { if (!xlocal) { XSYNC(); } else { asm volatile("s_waitcnt vmcnt(0)" ::: "memory"); __syncthreads(); \
        if (threadIdx.x == 0) { unsigned long long off_l = WS_LBAR; asm volatile("" : "+s"(off_l)); unsigned* lb = (unsigned*)(ws + off_l); unsigned xx = xb_xcc_id(); asm volatile("" : "+s"(xx)); \
            const unsigned nloc = gridDim.x >> 3, old = xb_add(&lb[64 * xx], 1u), gen = old / nloc; \
            if (old + 1u == (gen + 1u) * nloc) xb_add(&lb[1024 + 64 * xx], 1u); else XB_SPIN(xb_ld(&lb[1024 + 64 * xx]) == gen, (unsigned*)(ws + WS_BAR)); \
            __builtin_amdgcn_fence(__ATOMIC_ACQUIRE, "agent"); asm volatile("s_waitcnt vmcnt(0)" ::: "memory"); } \
        __syncthreads(); } } while (0)

    for (int step = 0; step < 3 * DEPTH; ++step) {
        const int l = step / 3, kind = step - 3 * l;
        bf16_t* slot = Wb + (size_t)(l & 1) * SLOT_ELEMS;
        if (kind != 1) {
            const bf16_t* Wup = slot + (kind == 0 ? OFF_UP1 : OFF_UP2); const bf16_t* Wdn = slot + (kind == 0 ? OFF_DN1 : OFF_DN2);
            for (int rp = 0; rp <= REP_FA; ++rp) {
            { const int pm0 = stage_rstd(lds, SS + (size_t)step * M * 16, 2 * DFF); EpiSwiglu E{ACT, SS + (size_t)step * M * 16, (const LAS float*)(lds + RS_OFF), pm0}; run_gemm(lds, XB, Wup, 2 * DFF, D, E); }
            XSYNC_L(); }
            for (int rp = 0; rp < REP_SYNC; ++rp) XSYNC();
            { EpiResid E{XB, SS + (size_t)(step + 1) * M * 16, 0.5f}; run_gemm(lds, ACT, Wdn, D, DFF, E); }
            if (step == 3 * DEPTH - 1) XSYNC(); else XSYNC_L();
            for (int rp = 0; rp < REP_FB; ++rp) {
            { EpiResid E{XB, SS + (size_t)(step + 1) * M * 16, 0.0f}; run_gemm(lds, ACT, Wdn, D, DFF, E); }
            XSYNC(); }
        } else {
            for (int rp = 0; rp <= REP_M1; ++rp) {
            { const int pm0 = stage_rstd(lds, SS + (size_t)step * M * 16, INW); EpiProj E{P1, P2, SS + (size_t)step * M * 16, (const LAS float*)(lds + RS_OFF), pm0}; run_gemm(lds, XB, slot + OFF_WIN, INW, D, E); }
            XSYNC(); }
            MixP p; p.P1 = P1; p.P2 = P2; p.Wpool = slot + OFF_WPOOL; p.Wa = slot + OFF_WA; p.Wx = slot + OFF_WX; p.mixed = MIX; p.hl = HL; p.summ = SUMM;
            p.pool_b = a.pool_b + l * PW; p.pool_scale = a.pool_scale + l * PW; p.conv_w = a.conv_w + l * 4 * LW; p.conv_b = a.conv_b + l * LW;
            p.b_a = a.lru_b_a + l * LW; p.b_x = a.lru_b_x + l * LW; p.lam = a.lru_lambda + l * LW;
            for (int rp = 0; rp <= REP_M2; ++rp) {
            lru_pass<1>(lds, p, a, (l + 1 < DEPTH && rp == 0) ? l + 1 : -1, Wb + (size_t)((l + 1) & 1) * SLOT_ELEMS, (unsigned*)(ws + WS_CNT) + l);
            if (rp < REP_M2) XSYNC(); }
            XSYNC();
            for (int rp = 0; rp <= REP_M2; ++rp) {
            lru_pass<2>(lds, p, a, -1, nullptr, nullptr);
            XSYNC(); }
            for (int rp = 0; rp <= REP_M4; ++rp) {
            { EpiGateA E{TB, P2 + 1280}; run_gemm(lds, MIX, slot + OFF_WPU, D, PW, E); }
            { EpiGateB E{MRG, TB, P2 + 2304}; run_gemm(lds, HL, slot + OFF_WLU, D, LW, E); }
            XSYNC_L(); }
            { EpiResid E{XB, SS + (size_t)(step + 1) * M * 16, 1.0f}; run_gemm(lds, MRG, slot + OFF_WOUT, D, D, E); }
            XSYNC_L();
            for (int rp = 0; rp < REP_M5; ++rp) {
            { EpiResid E{XB, SS + (size_t)(step + 1) * M * 16, 0.0f}; run_gemm(lds, MRG, slot + OFF_WOUT, D, D, E); }
            XSYNC(); }
        }
    }
    {
        LANE_IDS();
        const float* ssf = SS + (size_t)12 * M * 16;
        f32x4 gv[4];
#pragma unroll
        for (int j = 0; j < 4; ++j) gv[j] = *((const f32x4*)a.final_norm + lane + 64 * j);
        for (int row0 = gw; row0 < M; row0 += 4 * NGW) {
            u32x2 w[4][4]; float rs[4];
#pragma unroll
            for (int u = 0; u < 4; ++u) { const int row = min(row0 + u * NGW, M - 1); const u32x2* xr = (const u32x2*)(XB + (size_t)row * D) + lane;
#pragma unroll
                for (int j = 0; j < 4; ++j) w[u][j] = xr[64 * j];
                rs[u] = row_rstd(ssf, row); }
#pragma unroll
            for (int u = 0; u < 4; ++u) { const int row = row0 + u * NGW; if (row >= M) break; f32x4* orow = (f32x4*)(a.out + (size_t)row * D) + lane;
#pragma unroll
                for (int j = 0; j < 4; ++j) orow[64 * j] = (f32x4){bflo(w[u][j].x), bfhi(w[u][j].x), bflo(w[u][j].y), bfhi(w[u][j].y)} * rs[u] * gv[j]; }
        }
    }
}

extern "C" void kernel_launch(void* const* d_in, const int* in_sizes, int n_in, void* d_out, int out_size, void* d_ws, size_t ws_size, hipStream_t stream) {
    static int grid = 0;
    if (!grid) {
        int dev = 0, cus = 0, per_cu = 0;
        if (n_in != 23 || out_size != M * D || ws_size < WS_END) { fprintf(stderr, "kernel_launch: unexpected problem: n_in %d out %d ws %zu (need %zu)\n", n_in, out_size, ws_size, (size_t)WS_END); }
        (void)hipGetDevice(&dev);
        (void)hipDeviceGetAttribute(&cus, hipDeviceAttributeMultiprocessorCount, dev);
        (void)hipFuncSetAttribute((const void*)fwd_mega, hipFuncAttributeMaxDynamicSharedMemorySize, LDS_BYTES);
        (void)hipOccupancyMaxActiveBlocksPerMultiprocessor(&per_cu, (const void*)fwd_mega, 512, LDS_BYTES);
        if (per_cu < 1) per_cu = 1;
        grid = cus * per_cu;
    }
    Args a{};
    const float** pp = (const float**)&a;
    for (int i = 0; i < 23; ++i) pp[i] = (const float*)d_in[i];
    a.out = (float*)d_out; a.ws = (unsigned char*)d_ws;
    void* args[] = {&a};
    hipError_t e = hipLaunchCooperativeKernel((const void*)fwd_mega, dim3(grid), dim3(512), args, LDS_BYTES, stream);
    if (e != hipSuccess) fprintf(stderr, "kernel_launch: cooperative launch failed: %s (grid %d)\n", hipGetErrorString(e), grid);
}
```

```cpp
#include <hip/hip_runtime.h>
#include <hip/hip_cooperative_groups.h>
#include <cstdio>
#include <cstdint>
namespace cg = cooperative_groups;
namespace pg8 {
#define PG8_LAS __attribute__((address_space(3)))
typedef unsigned short bf16_t;
typedef short bf16x8 __attribute__((ext_vector_type(8)));
typedef float f32x4 __attribute__((ext_vector_type(4)));
typedef unsigned u32x4 __attribute__((ext_vector_type(4)));
constexpr int BM = 256, BK = 64, HALF = 128, HTB = HALF * BK * 2  , STAGE_BYTES = 8 * HTB, NXCD = 8, WGM = 8;

__host__ __device__ __forceinline__ int lds_byte(int r, int c) { const int st = (r >> 4) * 2 + (c >> 5), rr = r & 15, cc = c & 31, ob = rr * 64 + cc * 2; return st * 1024 + (ob ^ (((ob >> 9) & 1) << 5)); }
__host__ __device__ __forceinline__ void stage_rc(int b, int& R, int& C) { const int st = b / 1024, sb = b % 1024, swz = sb ^ (((sb >> 9) & 1) << 5); R = (st >> 1) * 16 + swz / 64; C = (st & 1) * 32 + (swz % 64) / 2; }
__host__ __device__ __forceinline__ int perm32(int rho) { const int n = rho >> 4, i = rho & 15; return 8 * (i >> 2) + 4 * n + (i & 3); }

struct Unit { int pm, pn; };
struct Gemm { const bf16_t* A; const bf16_t* Bt; int M, N, K; };

struct StaticOrder {
    int nM, nN, nwg, G, c;
    __host__ __device__ void init(int M, int N, int G_, int c_) { nM = M / BM; nN = N / BM; nwg = nM * nN; G = G_; c = c_; }
    __host__ __device__ bool next(int i, Unit& u) const {
        const long L = (long)i * G + c; if (L >= nwg) return false;
        int wgid = (int)L; { const int q = nwg / NXCD, r = nwg % NXCD, xcd = wgid % NXCD, off = wgid / NXCD; wgid = (xcd < r ? xcd * (q + 1) : r * (q + 1) + (xcd - r) * q) + off; }
        const int nig = WGM * nN, gid = wgid / nig, fm = gid * WGM, gsz = (nM - fm) < WGM ? (nM - fm) : WGM;
        u.pm = fm + ((wgid % nig) % gsz); u.pn = (wgid % nig) / gsz; return true;
    }
    __device__ __forceinline__ void a_ready(const Unit&) const {}
    __device__ __forceinline__ void done(const Unit&) const {}
};

template <class Epi, class Sched, bool ALIGN_EPI = false, bool SP2 = false>
__device__ __forceinline__ void gemm_phase(PG8_LAS unsigned char* lds, const Gemm g, const Sched& S, const Epi& E) {
    int tid_l = threadIdx.x; asm volatile("" : "+v"(tid_l));
    const int tid = tid_l, wid = __builtin_amdgcn_readfirstlane(tid >> 6), lane = tid & 63, wr = wid >> 2, wc = wid & 3, fr = lane & 15, fq = lane >> 4;
    const int K = g.K, nt = K / BK;
    unsigned voffA[2], voffB[2];
#pragma unroll
    for (int i = 0; i < 2; ++i) { int R, C; stage_rc(tid * 16 + i * 8192, R, C); const int Rb = Epi::PERM ? ((R & ~31) + perm32(R & 31)) : R;
        voffA[i] = (unsigned)(R * K + C) * 2u; voffB[i] = (unsigned)(Rb * K + C) * 2u; }
    const size_t kstep = (size_t)(BK * 2);
    const size_t hstep = (size_t)HALF * K * 2;
    const size_t tstep = 2 * hstep;
    const unsigned ldsw = (unsigned)wid * 1024u;
    const int aoff = lds_byte(wr * 64 + fr, fq * 8), boff = lds_byte(wc * 32 + fr, fq * 8);
#define PG8_SA(b, h) (((b) * 2 + (h)) * HTB)
#define PG8_SB(b, h) ((4 + (b) * 2 + (h)) * HTB)
#define PG8_STAGE(bufoff, gbase, voff) do { _Pragma("unroll") for (int _i = 0; _i < 2; ++_i) \
        __builtin_amdgcn_global_load_lds((const unsigned*)((const char*)(gbase) + (voff)[_i]), (PG8_LAS unsigned*)(lds + (bufoff) + ldsw + _i * 8192), 16, 0, 0); } while (0)
#define PG8_LDA(dst, b, h) do { _Pragma("unroll") for (int m = 0; m < 4; ++m) _Pragma("unroll") for (int k = 0; k < 2; ++k) dst[m][k] = *(const PG8_LAS bf16x8*)(lds + PG8_SA(b, h) + aoff + m * 2048 + k * 1024); } while (0)
#define PG8_LDB(dst, b, h) do { _Pragma("unroll") for (int n = 0; n < 2; ++n) _Pragma("unroll") for (int k = 0; k < 2; ++k) dst[n][k] = *(const PG8_LAS bf16x8*)(lds + PG8_SB(b, h) + boff + n * 2048 + k * 1024); } while (0)
#define PG8_MMA(ai, bj, At, Bt) do { __builtin_amdgcn_s_setprio(1); _Pragma("unroll") for (int m = 0; m < 4; ++m) _Pragma("unroll") for (int n = 0; n < 2; ++n) _Pragma("unroll") for (int k = 0; k < 2; ++k) \
        acc[ai][bj][m][n] = __builtin_amdgcn_mfma_f32_16x16x32_bf16(Bt[n][k], At[m][k], acc[ai][bj][m][n], 0, 0, 0); __builtin_amdgcn_s_setprio(0); } while (0)
#define PG8_WAIT_V(n) asm volatile("s_waitcnt vmcnt(" #n ")" ::: "memory")
#define PG8_WAIT_L(n) asm volatile("s_waitcnt lgkmcnt(" #n ")" ::: "memory")
#define PG8_BAR __builtin_amdgcn_s_barrier()
#define PG8_SCHED __builtin_amdgcn_sched_barrier(0)
    Unit cur, nxt; int ui = 0;
    if (!S.next(0, cur)) return;
    f32x4 acc[2][2][4][2];
#pragma unroll
    for (int a = 0; a < 2; ++a)
#pragma unroll
        for (int b = 0; b < 2; ++b)
#pragma unroll
            for (int m = 0; m < 4; ++m)
#pragma unroll
                for (int n = 0; n < 2; ++n) acc[a][b][m][n] = (f32x4){0.f, 0.f, 0.f, 0.f};
    bf16x8 At[4][2], B0[2][2], B1[2][2];
    const char* cA = (const char*)g.A + (size_t)cur.pm * tstep; const char* cB = (const char*)g.Bt + (size_t)cur.pn * tstep;
    S.a_ready(cur);
    if constexpr (SP2) {
        PG8_STAGE(PG8_SB(0, 0), cB, voffB); PG8_STAGE(PG8_SB(0, 1), cB + hstep, voffB); PG8_STAGE(PG8_SA(0, 0), cA, voffA); PG8_STAGE(PG8_SA(0, 1), cA + hstep, voffA);
        if (wr == 1) PG8_BAR;
        PG8_WAIT_V(2); PG8_BAR;
        PG8_STAGE(PG8_SB(1, 0), cB + kstep, voffB); PG8_STAGE(PG8_SA(1, 0), cA + kstep, voffA); PG8_STAGE(PG8_SB(1, 1), cB + hstep + kstep, voffB);
        PG8_WAIT_V(6); PG8_BAR;
    } else {
        PG8_STAGE(PG8_SB(0, 0), cB, voffB); PG8_STAGE(PG8_SA(0, 0), cA, voffA); PG8_STAGE(PG8_SB(0, 1), cB + hstep, voffB); PG8_STAGE(PG8_SA(0, 1), cA + hstep, voffA);
        if (wr == 1) PG8_BAR;
        PG8_WAIT_V(4); PG8_BAR;
        PG8_STAGE(PG8_SB(1, 0), cB + kstep, voffB); PG8_STAGE(PG8_SA(1, 0), cA + kstep, voffA); PG8_STAGE(PG8_SB(1, 1), cB + hstep + kstep, voffB);
        PG8_WAIT_V(6); PG8_BAR;
    }
    for (;;) {
        const bool has_next = S.next(ui + 1, nxt);
        const char* nA = has_next ? (const char*)g.A + (size_t)nxt.pm * tstep : cA; const char* nB = has_next ? (const char*)g.Bt + (size_t)nxt.pn * tstep : cB;
        for (int t = 0; t < nt; t += 2) {
            const bool last = (t == nt - 2);
            const char* a1 = cA + (size_t)(t + 1) * kstep;
            const char* a2 = last ? nA : cA + (size_t)(t + 2) * kstep; const char* b2 = last ? nB : cB + (size_t)(t + 2) * kstep;
            const char* a3 = a2 + kstep; const char* b3 = b2 + kstep;
            if (last && has_next) S.a_ready(nxt);
            if constexpr (SP2) {
            PG8_LDB(B0, 0, 0); PG8_LDB(B1, 0, 1); PG8_SCHED; PG8_LDA(At, 0, 0); PG8_STAGE(PG8_SA(1, 1), a1 + hstep, voffA);
            PG8_WAIT_V(8); PG8_WAIT_L(0); PG8_BAR; PG8_MMA(0, 0, At, B0); PG8_MMA(0, 1, At, B1); PG8_BAR; PG8_SCHED;
            PG8_LDA(At, 0, 1); PG8_STAGE(PG8_SB(0, 0), b2, voffB); PG8_STAGE(PG8_SB(0, 1), b2 + hstep, voffB); PG8_STAGE(PG8_SA(0, 0), a2, voffA);
            PG8_WAIT_V(8); PG8_WAIT_L(0); PG8_BAR; PG8_MMA(1, 0, At, B0); PG8_MMA(1, 1, At, B1); PG8_BAR; PG8_SCHED;
            PG8_LDB(B0, 1, 0); PG8_LDB(B1, 1, 1); PG8_SCHED; PG8_LDA(At, 1, 0); PG8_STAGE(PG8_SA(0, 1), a2 + hstep, voffA);
            PG8_WAIT_V(8); PG8_WAIT_L(0); PG8_BAR; PG8_MMA(0, 0, At, B0); PG8_MMA(0, 1, At, B1); PG8_BAR; PG8_SCHED;
            PG8_LDA(At, 1, 1); PG8_STAGE(PG8_SB(1, 0), b3, voffB); PG8_STAGE(PG8_SB(1, 1), b3 + hstep, voffB); PG8_STAGE(PG8_SA(1, 0), a3, voffA);
            PG8_WAIT_V(8); PG8_WAIT_L(0); PG8_BAR; PG8_MMA(1, 0, At, B0); PG8_MMA(1, 1, At, B1); PG8_BAR; PG8_SCHED;
            } else {
            PG8_LDB(B0, 0, 0); PG8_SCHED; PG8_LDA(At, 0, 0); PG8_STAGE(PG8_SA(1, 1), a1 + hstep, voffA);
            PG8_WAIT_L(8); PG8_BAR; PG8_WAIT_L(0); PG8_MMA(0, 0, At, B0); PG8_BAR; PG8_SCHED;
            PG8_LDB(B1, 0, 1); PG8_STAGE(PG8_SB(0, 0), b2, voffB);
            PG8_BAR; PG8_WAIT_L(0); PG8_MMA(0, 1, At, B1); PG8_BAR;
            PG8_LDA(At, 0, 1); PG8_STAGE(PG8_SA(0, 0), a2, voffA);
            PG8_BAR; PG8_WAIT_L(0); PG8_MMA(1, 0, At, B0); PG8_BAR; PG8_SCHED;
            PG8_STAGE(PG8_SB(0, 1), b2 + hstep, voffB);
            PG8_WAIT_V(6); PG8_BAR; PG8_MMA(1, 1, At, B1); PG8_BAR;
            PG8_LDB(B0, 1, 0); PG8_SCHED; PG8_LDA(At, 1, 0); PG8_STAGE(PG8_SA(0, 1), a2 + hstep, voffA);
            PG8_WAIT_L(8); PG8_BAR; PG8_WAIT_L(0); PG8_MMA(0, 0, At, B0); PG8_BAR; PG8_SCHED;
            PG8_LDB(B1, 1, 1); PG8_STAGE(PG8_SB(1, 0), b3, voffB);
            PG8_BAR; PG8_WAIT_L(0); PG8_MMA(0, 1, At, B1); PG8_BAR;
            PG8_LDA(At, 1, 1); PG8_STAGE(PG8_SA(1, 0), a3, voffA);
            PG8_BAR; PG8_WAIT_L(0); PG8_MMA(1, 0, At, B0); PG8_BAR; PG8_SCHED;
            PG8_STAGE(PG8_SB(1, 1), b3 + hstep, voffB);
            PG8_WAIT_V(6); PG8_BAR; PG8_MMA(1, 1, At, B1); PG8_BAR;
            }
        }
        if constexpr (ALIGN_EPI) { if (wr == 0) PG8_BAR; }
        if constexpr (!Epi::AFTER_DRAIN) { E(acc, cur, wr, wc, fr, fq); S.done(cur); }
        if (!has_next) break;
#pragma unroll
        for (int a = 0; a < 2; ++a)
#pragma unroll
            for (int b = 0; b < 2; ++b)
#pragma unroll
                for (int m = 0; m < 4; ++m)
#pragma unroll
                    for (int n = 0; n < 2; ++n) acc[a][b][m][n] = (f32x4){0.f, 0.f, 0.f, 0.f};
        cur = nxt; cA = nA; cB = nB; ++ui;
        if constexpr (ALIGN_EPI) { if (wr == 1) PG8_BAR; }
    }
    PG8_WAIT_V(0);
    if constexpr (!ALIGN_EPI) { if (wr == 0) PG8_BAR; }
    PG8_BAR;
    if constexpr (Epi::AFTER_DRAIN) { E.fused(acc, cur, wr, wc, fr, fq, lds, wid, lane); S.done(cur); }
#undef PG8_SA
#undef PG8_SB
#undef PG8_STAGE
#undef PG8_LDA
#undef PG8_LDB
#undef PG8_MMA
#undef PG8_WAIT_V
#undef PG8_WAIT_L
#undef PG8_BAR
#undef PG8_SCHED
}
}

#define LAS __attribute__((address_space(3)))
typedef unsigned short bf16_t;
using pg8::f32x4; using pg8::u32x4; using pg8::bf16x8; using pg8::Unit;
__device__ __forceinline__ unsigned cvt_pk_bf16(float lo, float hi) { unsigned r; asm volatile("v_cvt_pk_bf16_f32 %0, %1, %2" : "=v"(r) : "v"(lo), "v"(hi)); return r; }
typedef float f32x2 __attribute__((ext_vector_type(2)));
typedef unsigned u32x2 __attribute__((ext_vector_type(2)));

#define XB_TMO      128
#define XB_XCNT(j)  (256  + 64 * (j))
#define XB_XSUB(j)  (1280 + 64 * (j))
#define XB_XGEN(j)  (2304 + 64 * (j))
#define XB_TOP      3328
#define XB_TOPGEN   3392
#define XCD_BAR_WORDS 3456
#define XB_SPIN_CAP (1u << 18)

__device__ __forceinline__ unsigned xb_ld(unsigned* p)              { return __hip_atomic_load(p, __ATOMIC_RELAXED, __HIP_MEMORY_SCOPE_AGENT); }
__device__ __forceinline__ unsigned xb_add(unsigned* p, unsigned v) { return __hip_atomic_fetch_add(p, v, __ATOMIC_RELAXED, __HIP_MEMORY_SCOPE_AGENT); }
__device__ __forceinline__ unsigned xb_xcc_id() { return (unsigned)__builtin_amdgcn_s_getreg((3 << 11) | 20) & 0xFu; }
#define XB_SPIN(cond, bar) do { unsigned _sp = 0; while (cond) { __builtin_amdgcn_s_sleep(1); \
    if ((++_sp & 255u) == 0u) { if (xb_ld(&(bar)[XB_TMO])) break; if (_sp > XB_SPIN_CAP) { atomicAdd(&(bar)[XB_TMO], 1u); break; } } } } while (0)

struct XcdBarrier {
    unsigned* bar; unsigned x;
    volatile LAS unsigned* st;
};

__device__ __forceinline__ XcdBarrier xcd_barrier_post(unsigned* bar, volatile LAS unsigned* st) {
    XcdBarrier b; b.bar = bar; b.x = xb_xcc_id(); b.st = st;
    if (threadIdx.x == 0) (void)xb_add(&bar[XB_XCNT(b.x)], 1u);
    return b;
}
__device__ __forceinline__ void xcd_barrier_complete(unsigned* bar, unsigned x, unsigned& nloc, unsigned& nx) {
    const unsigned G = gridDim.x * gridDim.y * gridDim.z;
    unsigned sum, cnt, mine, sp = 0u;
    for (;;) {
        sum = 0u; cnt = 0u; mine = 0u;
#pragma unroll
        for (unsigned j = 0; j < 16; ++j) { const unsigned c = xb_ld(&bar[XB_XCNT(j)]); sum += c; cnt += (c > 0u) ? 1u : 0u; mine = (j == x) ? c : mine; }
        if (sum == G) break;
        __builtin_amdgcn_s_sleep(1);
        if ((++sp & 255u) == 0u) { if (xb_ld(&bar[XB_TMO])) break; if (sp > XB_SPIN_CAP) { atomicAdd(&bar[XB_TMO], 1u); break; } }
    }
    nloc = mine > 0u ? mine : 1u; nx = cnt > 0u ? cnt : 1u;
}

__device__ __forceinline__ void xcd_barrier(const XcdBarrier& b) {
    asm volatile("s_waitcnt vmcnt(0)" ::: "memory");
    __syncthreads();
    if (threadIdx.x == 0) {
        unsigned* bar = b.bar;
        __builtin_amdgcn_s_waitcnt(0);
        unsigned nloc = b.st[0], nx = b.st[1];
        if (nloc == 0u) { xcd_barrier_complete(bar, b.x, nloc, nx); b.st[0] = nloc; b.st[1] = nx; }
        const unsigned old = xb_add(&bar[XB_XSUB(b.x)], 1u);
        const unsigned gen = old / nloc;
        if (old + 1u == (gen + 1u) * nloc) {
            __builtin_amdgcn_fence(__ATOMIC_RELEASE, "agent");
            asm volatile("s_waitcnt vmcnt(0)" ::: "memory");
            const unsigned og = xb_add(&bar[XB_TOP], 1u);
            const unsigned tg = og / nx;
            if (og + 1u == (tg + 1u) * nx) xb_add(&bar[XB_TOPGEN], 1u);
            else XB_SPIN(xb_ld(&bar[XB_TOPGEN]) == tg, bar);
            __builtin_amdgcn_fence(__ATOMIC_ACQUIRE, "agent");
            xb_add(&bar[XB_XGEN(b.x)], 1u);
            asm volatile("s_waitcnt vmcnt(0)" ::: "memory");
        } else {
            XB_SPIN(xb_ld(&bar[XB_XGEN(b.x)]) == gen, bar);
            __builtin_amdgcn_fence(__ATOMIC_ACQUIRE, "agent");
            asm volatile("s_waitcnt vmcnt(0)" ::: "memory");
        }
    }
    __syncthreads();
}


constexpr int D = 1024, SEQ = 2048, M = 16384, DEPTH = 4;
constexpr int PW = 512, LW = 1280, DFF = 2816, INW = 5120, P1W = 1792, P2W = 3328;
constexpr float EPS = 1e-6f, LOG2E_ = 1.4426950408889634f;
constexpr int NCH = 64, CT = 32;

constexpr size_t OFF_UP1 = 0, OFF_DN1 = OFF_UP1 + (size_t)2 * DFF * D, OFF_WIN = OFF_DN1 + (size_t)D * DFF, OFF_WPU = OFF_WIN + (size_t)INW * D,
                 OFF_WLU = OFF_WPU + (size_t)D * PW, OFF_WOUT = OFF_WLU + (size_t)D * LW, OFF_UP2 = OFF_WOUT + (size_t)D * D, OFF_DN2 = OFF_UP2 + (size_t)2 * DFF * D,
                 OFF_WPOOL = OFF_DN2 + (size_t)D * DFF, OFF_WA = OFF_WPOOL + (size_t)128 * PW, OFF_WX = OFF_WA + (size_t)128 * LW, SLOT_ELEMS = OFF_WX + (size_t)128 * LW;
constexpr size_t WS_W = 0, WS_XB = WS_W + 2 * SLOT_ELEMS * 2, WS_R = WS_XB + (size_t)M * D * 2, WS_MIX = WS_R + (size_t)M * INW * 2, WS_HL = WS_MIX + (size_t)M * PW * 2,
                 WS_MERGED = WS_HL + (size_t)M * LW * 2, WS_SS = WS_MERGED + (size_t)M * D * 2, WS_SUM = WS_SS + (size_t)13 * M * 16 * 4, WS_BAR = WS_SUM + (size_t)8 * NCH * LW * 2 * 4, WS_CNT = WS_BAR + (size_t)XCD_BAR_WORDS * 4, WS_LBAR = WS_CNT + 256, WS_END = WS_LBAR + 2048 * 4;
constexpr int MISC_OFF = 144 * 1024, RS_OFF = MISC_OFF + 1024, LDS_BYTES = RS_OFF + 1024;

struct Args {
    const float *x, *norm_ffn1, *ffn1_w_up, *ffn1_w_down, *norm_mix, *w_in, *pool_w, *pool_b, *pool_scale, *w_pool_up, *conv_w, *conv_b, *lru_w_a, *lru_b_a, *lru_w_x, *lru_b_x,
                *lru_lambda, *w_lru_up, *w_out, *norm_ffn2, *ffn2_w_up, *ffn2_w_down, *final_norm;
    float* out; unsigned char* ws;
};

__device__ __forceinline__ float bflo(unsigned w) { return __uint_as_float(w << 16); }
__device__ __forceinline__ float bfhi(unsigned w) { return __uint_as_float(w & 0xffff0000u); }
__device__ __forceinline__ float fsig(float v) { return __builtin_amdgcn_rcpf(1.0f + __expf(-v)); }
__device__ __forceinline__ float wave_sum(float v) {
#pragma unroll
    for (int o = 1; o < 64; o <<= 1) v += __shfl_xor(v, o);
    return v;
}
__device__ __forceinline__ float row_rstd(const float* ss, int row) {
    const f32x4* q = (const f32x4*)(ss + (size_t)row * 16); const f32x4 s4 = (q[0] + q[1]) + (q[2] + q[3]);
    return rsqrtf(((s4[0] + s4[1]) + (s4[2] + s4[3])) * (1.0f / D) + EPS);
}
__device__ __forceinline__ u32x4 pack8(const f32x4 a, const f32x4 b) { u32x4 w; w.x = cvt_pk_bf16(a[0], a[1]); w.y = cvt_pk_bf16(a[2], a[3]); w.z = cvt_pk_bf16(b[0], b[1]); w.w = cvt_pk_bf16(b[2], b[3]); return w; }

struct EpiSwiglu {
    static constexpr bool PERM = true, AFTER_DRAIN = false;
    bf16_t* O; const float* ss; const LAS float* RS; int pm0;
    __device__ __forceinline__ void operator()(const f32x4 (&acc)[2][2][4][2], const Unit& u, int wr, int wc, int fr, int fq) const {
        const int row0 = u.pm * 256 + wr * 64 + fr, col0 = u.pn * 128 + wc * 32 + 8 * fq;
#pragma unroll
        for (int ai = 0; ai < 2; ++ai)
#pragma unroll
            for (int m = 0; m < 4; ++m) {
                const int row = row0 + ai * 128 + m * 16; const float rs = (u.pm == pm0) ? RS[row & 255] : row_rstd(ss, row), rsl = -LOG2E_ * rs, rs2 = rs * rs;
                f32x4 t[2], q[2], e[2];
#pragma unroll
                for (int n = 0; n < 2; ++n) { t[n] = acc[ai][0][m][n] * rsl; q[n] = acc[ai][0][m][n] * acc[ai][1][m][n]; }
#pragma unroll
                for (int n = 0; n < 2; ++n)
#pragma unroll
                    for (int j = 0; j < 4; ++j) e[n][j] = __builtin_amdgcn_exp2f(t[n][j]);
#pragma unroll
                for (int n = 0; n < 2; ++n) { e[n] = e[n] + 1.0f; q[n] = q[n] * rs2; }
#pragma unroll
                for (int n = 0; n < 2; ++n)
#pragma unroll
                    for (int j = 0; j < 4; ++j) e[n][j] = __builtin_amdgcn_rcpf(e[n][j]);
                __builtin_nontemporal_store(pack8(q[0] * e[0], q[1] * e[1]), (u32x4*)(O + (size_t)row * DFF + col0));
            }
    }
};
struct EpiProj {
    static constexpr bool PERM = true, AFTER_DRAIN = false;
    bf16_t* P1; bf16_t* P2; const float* ss; const LAS float* RS; int pm0;
    __device__ __forceinline__ void operator()(const f32x4 (&acc)[2][2][4][2], const Unit& u, int wr, int wc, int fr, int fq) const {
        const int row0 = u.pm * 256 + wr * 64 + fr; const int kind = u.pn < 7 ? 0 : (u.pn < 12 ? 1 : 2);
        bf16_t* base = kind == 0 ? P1 : P2; const int ld = kind == 0 ? P1W : P2W; const int col0 = (kind == 0 ? u.pn : u.pn - 7) * 256 + wc * 32 + 8 * fq;
        const float c3 = kind == 1 ? -LOG2E_ * 1.5957691216f * 0.044715f : 0.f, c1 = kind == 1 ? -LOG2E_ * 1.5957691216f : -LOG2E_;
#pragma unroll
        for (int ai = 0; ai < 2; ++ai)
#pragma unroll
            for (int m = 0; m < 4; ++m) {
                const int row = row0 + ai * 128 + m * 16; const float rs = (u.pm == pm0) ? RS[row & 255] : row_rstd(ss, row);
#pragma unroll
                for (int bj = 0; bj < 2; ++bj) {
                    f32x4 v[2], e[2];
#pragma unroll
                    for (int n = 0; n < 2; ++n) { v[n] = acc[ai][bj][m][n] * rs; e[n] = v[n] * ((v[n] * v[n]) * c3 + c1); }
                    if (kind != 0) {
#pragma unroll
                        for (int n = 0; n < 2; ++n)
#pragma unroll
                            for (int j = 0; j < 4; ++j) e[n][j] = __builtin_amdgcn_exp2f(e[n][j]);
#pragma unroll
                        for (int n = 0; n < 2; ++n) e[n] = e[n] + 1.0f;
#pragma unroll
                        for (int n = 0; n < 2; ++n)
#pragma unroll
                            for (int j = 0; j < 4; ++j) e[n][j] = __builtin_amdgcn_rcpf(e[n][j]);
                        if (kind == 1) { v[0] = v[0] * e[0]; v[1] = v[1] * e[1]; } else { v[0] = e[0]; v[1] = e[1]; }
                    }
                    __builtin_nontemporal_store(pack8(v[0], v[1]), (u32x4*)(base + (size_t)row * ld + col0 + bj * 128));
                }
            }
    }
};
struct EpiResid {
    static constexpr bool PERM = true, AFTER_DRAIN = false;
    bf16_t* xb; float* ssn; float scale;
    __device__ __forceinline__ void operator()(const f32x4 (&acc)[2][2][4][2], const Unit& u, int wr, int wc, int fr, int fq) const {
        const int row0 = u.pm * 256 + wr * 64 + fr, col0 = u.pn * 256 + wc * 32 + 8 * fq;
#pragma unroll
        for (int ai = 0; ai < 2; ++ai)
#pragma unroll
            for (int m = 0; m < 4; ++m) {
                const int row = row0 + ai * 128 + m * 16; float p = 0.f;
#pragma unroll
                for (int bj = 0; bj < 2; ++bj) {
                    const size_t off = (size_t)row * D + col0 + bj * 128;
                    const u32x4 xx = *(const u32x4*)(xb + off);
                    const f32x4 x0 = (f32x4){bflo(xx.x), bfhi(xx.x), bflo(xx.y), bfhi(xx.y)}, x1 = (f32x4){bflo(xx.z), bfhi(xx.z), bflo(xx.w), bfhi(xx.w)};
                    const f32x4 y0 = x0 + acc[ai][bj][m][0] * scale, y1 = x1 + acc[ai][bj][m][1] * scale;
                    *(u32x4*)(xb + off) = pack8(y0, y1);
                    const f32x4 q = y0 * y0 + y1 * y1; p += (q[0] + q[1]) + (q[2] + q[3]);
                }
                p += __shfl_xor(p, 16); p += __shfl_xor(p, 32);
                if (fq == 0) ssn[(size_t)row * 16 + u.pn * 4 + wc] = p;
            }
    }
};
struct EpiGateA {
    static constexpr bool PERM = true, AFTER_DRAIN = false;
    bf16_t* T; const bf16_t* G;
    __device__ __forceinline__ void operator()(const f32x4 (&acc)[2][2][4][2], const Unit& u, int wr, int wc, int fr, int fq) const {
        const int row0 = u.pm * 256 + wr * 64 + fr, col0 = u.pn * 256 + wc * 32 + 8 * fq;
#pragma unroll
        for (int ai = 0; ai < 2; ++ai)
#pragma unroll
            for (int m = 0; m < 4; ++m) {
                const int row = row0 + ai * 128 + m * 16;
#pragma unroll
                for (int bj = 0; bj < 2; ++bj) {
                    const int c = col0 + bj * 128;
                    const u32x4 g = *(const u32x4*)(G + (size_t)row * P2W + c);
                    f32x4 o0 = acc[ai][bj][m][0], o1 = acc[ai][bj][m][1];
                    o0[0] *= bflo(g.x); o0[1] *= bfhi(g.x); o0[2] *= bflo(g.y); o0[3] *= bfhi(g.y); o1[0] *= bflo(g.z); o1[1] *= bfhi(g.z); o1[2] *= bflo(g.w); o1[3] *= bfhi(g.w);
                    *(u32x4*)(T + (size_t)row * D + c) = pack8(o0, o1);
                }
            }
    }
};
struct EpiGateB {
    static constexpr bool PERM = true, AFTER_DRAIN = false;
    bf16_t* O; const bf16_t* T; const bf16_t* G;
    __device__ __forceinline__ void operator()(const f32x4 (&acc)[2][2][4][2], const Unit& u, int wr, int wc, int fr, int fq) const {
        const int row0 = u.pm * 256 + wr * 64 + fr, col0 = u.pn * 256 + wc * 32 + 8 * fq;
#pragma unroll
        for (int ai = 0; ai < 2; ++ai)
#pragma unroll
            for (int m = 0; m < 4; ++m) {
                const int row = row0 + ai * 128 + m * 16;
#pragma unroll
                for (int bj = 0; bj < 2; ++bj) {
                    const int c = col0 + bj * 128;
                    const u32x4 g = *(const u32x4*)(G + (size_t)row * P2W + c);
                    const u32x4 t = *(const u32x4*)(T + (size_t)row * D + c);
                    f32x4 o0 = acc[ai][bj][m][0], o1 = acc[ai][bj][m][1];
                    o0[0] = o0[0] * bflo(g.x) + bflo(t.x); o0[1] = o0[1] * bfhi(g.x) + bfhi(t.x); o0[2] = o0[2] * bflo(g.y) + bflo(t.y); o0[3] = o0[3] * bfhi(g.y) + bfhi(t.y);
                    o1[0] = o1[0] * bflo(g.z) + bflo(t.z); o1[1] = o1[1] * bfhi(g.z) + bfhi(t.z); o1[2] = o1[2] * bflo(g.w) + bflo(t.w); o1[3] = o1[3] * bfhi(g.w) + bfhi(t.w);
                    *(u32x4*)(O + (size_t)row * D + c) = pack8(o0, o1);
                }
            }
    }
};

#ifndef GEMM_ALIGN
#define GEMM_ALIGN true
#endif
template <class Epi> __device__ __forceinline__ void run_gemm(LAS unsigned char* lds, const bf16_t* A, const bf16_t* Bt, int N, int K, const Epi& E) {
    pg8::Gemm g{A, Bt, M, N, K}; pg8::StaticOrder S; S.init(M, N, (int)gridDim.x, __builtin_amdgcn_readfirstlane(((volatile LAS int*)(lds + MISC_OFF))[6]));
    pg8::gemm_phase<Epi, pg8::StaticOrder, GEMM_ALIGN, true>(lds, g, S, E);
}

__device__ __forceinline__ int stage_rstd(LAS unsigned char* lds, const float* ss, int N) {
    pg8::StaticOrder S; S.init(M, N, (int)gridDim.x, __builtin_amdgcn_readfirstlane(((volatile LAS int*)(lds + MISC_OFF))[6]));
    pg8::Unit u; int pm0 = -1; if (S.next(0, u)) pm0 = u.pm;
    int tid_l = threadIdx.x; asm volatile("" : "+v"(tid_l));
    if (pm0 >= 0 && tid_l < 256) ((LAS float*)(lds + RS_OFF))[tid_l] = row_rstd(ss, pm0 * 256 + tid_l);
    __syncthreads();
    return pm0;
}

__device__ __forceinline__ void tr_item32(const float* W, int K, int N, bf16_t* WT, const float* gsc, bool swz, LAS float* scr, int item, int lane) {
    const int nblk = N / 64, kb = item / nblk, nb = item - kb * nblk, k0 = 32 * kb, n0 = 64 * nb;
    int rbase = n0;
    if (swz) { const int half = n0 >= DFF ? 1 : 0, hid = n0 - half * DFF; rbase = 256 * (hid >> 7) + 128 * half + (hid & 127); }
    const int kr = lane >> 3, n4 = lane & 7;
    f32x4 v[2][4];
#pragma unroll
    for (int hf = 0; hf < 2; ++hf)
#pragma unroll
        for (int i = 0; i < 4; ++i) v[hf][i] = *(const f32x4*)(W + (size_t)(k0 + kr + 8 * i) * N + n0 + 32 * hf + 4 * n4);
    if (gsc) {
#pragma unroll
        for (int i = 0; i < 4; ++i) { const float gg = gsc[k0 + kr + 8 * i]; v[0][i] = v[0][i] * gg; v[1][i] = v[1][i] * gg; }
    }
    const int c = lane & 3;
#pragma unroll
    for (int hf = 0; hf < 2; ++hf) {
#pragma unroll
        for (int i = 0; i < 4; ++i)
#pragma unroll
            for (int e = 0; e < 4; ++e) scr[(kr + 8 * i) * 33 + 4 * n4 + e] = v[hf][i][e];
        asm volatile("s_waitcnt lgkmcnt(0)" ::: "memory");
#pragma unroll
        for (int j = 0; j < 2; ++j) { const int n = (lane >> 2) + 16 * j; const LAS float* sp = scr + (8 * c) * 33 + n;
            u32x4 o; o.x = cvt_pk_bf16(sp[0 * 33], sp[1 * 33]); o.y = cvt_pk_bf16(sp[2 * 33], sp[3 * 33]); o.z = cvt_pk_bf16(sp[4 * 33], sp[5 * 33]); o.w = cvt_pk_bf16(sp[6 * 33], sp[7 * 33]);
            *(u32x4*)(WT + (size_t)(rbase + 32 * hf + n) * K + k0 + 8 * c) = o; }
        asm volatile("s_waitcnt lgkmcnt(0)" ::: "memory");
    }
}
constexpr int J_UP = (D / 32) * (2 * DFF / 64), J_DN = (DFF / 32) * (D / 64), J_IN = (D / 32) * (INW / 64), J_PU = (PW / 32) * (D / 64), J_LU = (LW / 32) * (D / 64), J_OUT = (D / 32) * (D / 64),
              J_PL = (PW / 32) * (128 / 64), J_WA = (LW / 32) * (128 / 64), J_LAYER = 2 * J_UP + 2 * J_DN + J_IN + J_PU + J_LU + J_OUT + J_PL + 2 * J_WA;
__device__ __forceinline__ void convert_item(const Args& a, int l, bf16_t* slot, LAS float* scr, int it, int lane) {
    int r = it; const float* W; int K, N; bf16_t* WT; const float* g = nullptr; bool swz = false;
    if (r < J_UP) { W = a.ffn1_w_up + (size_t)l * D * 2 * DFF; K = D; N = 2 * DFF; WT = slot + OFF_UP1; g = a.norm_ffn1 + l * D; swz = true; }
    else if ((r -= J_UP) < J_DN) { W = a.ffn1_w_down + (size_t)l * DFF * D; K = DFF; N = D; WT = slot + OFF_DN1; }
    else if ((r -= J_DN) < J_IN) { W = a.w_in + (size_t)l * D * INW; K = D; N = INW; WT = slot + OFF_WIN; g = a.norm_mix + l * D; }
    else if ((r -= J_IN) < J_PU) { W = a.w_pool_up + (size_t)l * PW * D; K = PW; N = D; WT = slot + OFF_WPU; }
    else if ((r -= J_PU) < J_LU) { W = a.w_lru_up + (size_t)l * LW * D; K = LW; N = D; WT = slot + OFF_WLU; }
    else if ((r -= J_LU) < J_OUT) { W = a.w_out + (size_t)l * D * D; K = D; N = D; WT = slot + OFF_WOUT; }
    else if ((r -= J_OUT) < J_UP) { W = a.ffn2_w_up + (size_t)l * D * 2 * DFF; K = D; N = 2 * DFF; WT = slot + OFF_UP2; g = a.norm_ffn2 + l * D; swz = true; }
    else if ((r -= J_UP) < J_DN) { W = a.ffn2_w_down + (size_t)l * DFF * D; K = DFF; N = D; WT = slot + OFF_DN2; }
    else if ((r -= J_DN) < J_PL) { W = a.pool_w + (size_t)l * PW * 128; K = PW; N = 128; WT = slot + OFF_WPOOL; }
    else if ((r -= J_PL) < J_WA) { W = a.lru_w_a + (size_t)l * LW * 128; K = LW; N = 128; WT = slot + OFF_WA; }
    else { r -= J_WA; W = a.lru_w_x + (size_t)l * LW * 128; K = LW; N = 128; WT = slot + OFF_WX; }
    tr_item32(W, K, N, WT, g, swz, scr, r, lane);
}
__device__ __forceinline__ void convert_layer(const Args& a, int l, bf16_t* slot, LAS float* scr, int gw, int NGW, int lane) {
    for (int it = gw; it < J_LAYER; it += NGW) convert_item(a, l, slot, scr, it, lane);
}
__device__ __forceinline__ void convert_dynamic(const Args& a, int l, bf16_t* slot, LAS float* scr, unsigned* counter, int lane) {
    for (;;) {
        unsigned it = 0u; if (lane == 0) it = __hip_atomic_fetch_add(counter, 4u, __ATOMIC_RELAXED, __HIP_MEMORY_SCOPE_AGENT);
        it = (unsigned)__builtin_amdgcn_readfirstlane((int)it);
        if (it >= (unsigned)J_LAYER) break;
        for (unsigned u = 0; u < 4u && it + u < (unsigned)J_LAYER; ++u) convert_item(a, l, slot, scr, (int)(it + u), lane);
    }
}

constexpr int WROW = 272, WA_OFF = 0, WX_OFF = 128 * WROW, WP_OFF = 2 * 128 * WROW, CP_OFF = 3 * 128 * WROW, VW_OFF = CP_OFF + 4096, VW_BYTES = 16 * WROW;
static_assert(VW_BYTES >= 32 * 33 * 4 && VW_OFF + 8 * VW_BYTES <= MISC_OFF, "LDS map");
constexpr float LOG2E = 1.4426950408889634f;
struct MixP {
    const bf16_t *P1, *P2, *Wpool, *Wa, *Wx; bf16_t *mixed, *hl; float* summ;
    const float *pool_b, *pool_scale, *conv_w, *conv_b, *b_a, *b_x, *lam;
};
__device__ __forceinline__ float fsig2(float x) { return __builtin_amdgcn_rcpf(1.0f + __builtin_amdgcn_exp2f(-LOG2E * x)); }

__device__ __forceinline__ void stage_w(LAS unsigned char* lds, int off, const bf16_t* Wt, int ldk, int kofs, int tid) {
#pragma unroll 1
    for (int i = 0; i < 4; ++i) { const int idx = tid + 512 * i, row = idx >> 4, c16 = idx & 15;
        *(LAS u32x4*)(lds + off + row * WROW + c16 * 16) = *(const u32x4*)(Wt + (size_t)row * ldk + kofs + c16 * 8); }
}
__device__ __forceinline__ void stage_w2(LAS unsigned char* lds, int off0, const bf16_t* W0, int off1, const bf16_t* W1, int ldk, int kofs, int tid) {
    int t_ = tid; asm volatile("" : "+v"(t_));
    const int row = t_ >> 4, c16 = t_ & 15; const size_t go = (size_t)row * ldk + kofs + c16 * 8; const int lo = row * WROW + c16 * 16;
    u32x4 v0[4], v1[4];
#pragma unroll
    for (int i = 0; i < 4; ++i) { v0[i] = *(const u32x4*)(W0 + go + (size_t)(32 * i) * ldk); v1[i] = *(const u32x4*)(W1 + go + (size_t)(32 * i) * ldk); }
#pragma unroll
    for (int i = 0; i < 4; ++i) { *(LAS u32x4*)(lds + off0 + lo + 32 * i * WROW) = v0[i]; *(LAS u32x4*)(lds + off1 + lo + 32 * i * WROW) = v1[i]; }
}

template <int PASS> __device__ __forceinline__ void lru_wave_item(LAS unsigned char* lds, LAS unsigned char* vw, int b, int c, int h, const MixP& p, int lane, float (&Hrun)[8], bool cont) {
    const int fr = lane & 15, fq = lane >> 4, cg = fr;
    const LAS float* CP = (const LAS float*)(lds + CP_OFF);
    const int row0 = b * SEQ + c * CT;
    f32x2 wv[4][4], bv[4];
#pragma unroll
    for (int k = 0; k < 4; ++k) { const f32x4 w0 = *(const LAS f32x4*)(CP + k * 128 + cg * 8), w1 = *(const LAS f32x4*)(CP + k * 128 + cg * 8 + 4);
        wv[k][0] = (f32x2){w0[0], w0[1]}; wv[k][1] = (f32x2){w0[2], w0[3]}; wv[k][2] = (f32x2){w1[0], w1[1]}; wv[k][3] = (f32x2){w1[2], w1[3]}; }
    { const f32x4 b0 = *(const LAS f32x4*)(CP + 4 * 128 + cg * 8), b1 = *(const LAS f32x4*)(CP + 4 * 128 + cg * 8 + 4);
      bv[0] = (f32x2){b0[0], b0[1]}; bv[1] = (f32x2){b0[2], b0[3]}; bv[2] = (f32x2){b1[0], b1[1]}; bv[3] = (f32x2){b1[2], b1[3]}; }
    bf16x8 idf[2];
#pragma unroll
    for (int e = 0; e < 2; ++e)
#pragma unroll
        for (int i = 0; i < 8; ++i) idf[e][i] = (16 * e + fr - 8 * fq == i) ? (short)0x3F80 : (short)0;
    float pba[8], pbx[8], pk8[8], Arun[8];
#pragma unroll
    for (int n = 0; n < 8; ++n) { pba[n] = CP[5 * 128 + 16 * n + fr]; pbx[n] = CP[6 * 128 + 16 * n + fr]; pk8[n] = CP[7 * 128 + 16 * n + fr]; Arun[n] = 1.f; if (PASS == 1 || !cont) Hrun[n] = 0.f; }
    if (PASS == 2 && !cont) {
        float h0 = 0.f, h1 = 0.f; const float* sp = p.summ + ((size_t)b * NCH * LW + h * 128 + 32 * fq + fr) * 2;
        for (int cc0 = 0; cc0 < c; cc0 += 8) {
            f32x2 sa[8], sb[8];
#pragma unroll
            for (int u = 0; u < 8; ++u) { const int cc = min(cc0 + u, c - 1); sa[u] = *(const f32x2*)(sp + (size_t)cc * LW * 2); sb[u] = *(const f32x2*)(sp + (size_t)cc * LW * 2 + 32); }
#pragma unroll
            for (int u = 0; u < 8; ++u) if (cc0 + u < c) { h0 = sa[u].x * h0 + sa[u].y; h1 = sb[u].x * h1 + sb[u].y; }
        }
#pragma unroll
        for (int n = 0; n < 8; ++n) Hrun[n] = __shfl((n & 1) ? h1 : h0, fr + 16 * (n >> 1));
    }
    const bf16_t* ub = p.P1 + (size_t)(b * SEQ) * P1W + PW + h * 128 + cg * 8;
#pragma unroll 1
    for (int st = 0; st < CT / 16; ++st) {
        const int s0 = c * CT + 16 * st;
        u32x4 ur[7];
        {
            const int sb = s0 + 4 * fq - 3;
#pragma unroll
            for (int r = 0; r < 7; ++r) ur[r] = *(const u32x4*)(ub + (size_t)max(sb + r, 0) * P1W);
        }
        if (s0 == 0 && fq == 0) {
#pragma unroll
            for (int r = 0; r < 3; ++r) ur[r] = (u32x4){0u, 0u, 0u, 0u};
        }
#pragma unroll
        for (int jj = 0; jj < 4; ++jj) {
            f32x2 o[4] = {bv[0], bv[1], bv[2], bv[3]};
#pragma unroll
            for (int k = 0; k < 4; ++k) { const u32x4 uk = ur[jj + k];
                o[0] = wv[k][0] * (f32x2){bflo(uk.x), bfhi(uk.x)} + o[0]; o[1] = wv[k][1] * (f32x2){bflo(uk.y), bfhi(uk.y)} + o[1];
                o[2] = wv[k][2] * (f32x2){bflo(uk.z), bfhi(uk.z)} + o[2]; o[3] = wv[k][3] * (f32x2){bflo(uk.w), bfhi(uk.w)} + o[3]; }
            { u32x4 w; w.x = cvt_pk_bf16(o[0].x, o[0].y); w.y = cvt_pk_bf16(o[1].x, o[1].y); w.z = cvt_pk_bf16(o[2].x, o[2].y); w.w = cvt_pk_bf16(o[3].x, o[3].y);
              *(LAS u32x4*)(vw + (4 * fq + jj) * WROW + cg * 16) = w; }
        }

        f32x4 aR[8], aI[8];
        bf16x8 af[4];
        {
#pragma unroll
            for (int kk = 0; kk < 4; ++kk) af[kk] = *(const LAS bf16x8*)(vw + fr * WROW + kk * 64 + fq * 16);
#pragma unroll
            for (int n = 0; n < 8; ++n) {
                aR[n] = (f32x4){0.f, 0.f, 0.f, 0.f}; aI[n] = (f32x4){0.f, 0.f, 0.f, 0.f};
#pragma unroll
                for (int kk = 0; kk < 4; ++kk) {
                    const bf16x8 ba = *(const LAS bf16x8*)(lds + WA_OFF + (16 * n + fr) * WROW + kk * 64 + fq * 16);
                    const bf16x8 bx = *(const LAS bf16x8*)(lds + WX_OFF + (16 * n + fr) * WROW + kk * 64 + fq * 16);
                    aR[n] = __builtin_amdgcn_mfma_f32_16x16x32_bf16(af[kk], ba, aR[n], 0, 0, 0);
                    aI[n] = __builtin_amdgcn_mfma_f32_16x16x32_bf16(af[kk], bx, aI[n], 0, 0, 0);
                }
            }
        }
#pragma unroll
        for (int n = 0; n < 8; ++n) {
            const f32x4 aVn = __builtin_amdgcn_mfma_f32_16x16x32_bf16(af[n >> 1], idf[n & 1], (f32x4){0.f, 0.f, 0.f, 0.f}, 0, 0, 0);
            float av[4], bxv[4];
#pragma unroll
            for (int j = 0; j < 4; ++j) {
                const float r = fsig2(aR[n][j] + pba[n]), ig = fsig2(aI[n][j] + pbx[n]);
                const float a = __builtin_amdgcn_exp2f(r * pk8[n]), mult = __builtin_amdgcn_sqrtf(fmaxf(1.0f - a * a, 0.f));
                av[j] = a; bxv[j] = mult * ig * aVn[j];
            }
            const float H0 = bxv[0], H1 = av[1] * H0 + bxv[1], H2 = av[2] * H1 + bxv[2], H3 = av[3] * H2 + bxv[3];
            const float A0 = av[0], A1 = av[1] * A0, A2 = av[2] * A1, A3 = av[3] * A2;
            float At[4], Ht[4];
#pragma unroll
            for (int q = 0; q < 4; ++q) { At[q] = __shfl(A3, fr + 16 * q); Ht[q] = __shfl(H3, fr + 16 * q); }
            const float c0 = Hrun[n], c1 = At[0] * c0 + Ht[0], c2 = At[1] * c1 + Ht[1], c3 = At[2] * c2 + Ht[2], c4 = At[3] * c3 + Ht[3];
            Hrun[n] = c4;
            if (PASS == 1) Arun[n] *= (At[0] * At[1]) * (At[2] * At[3]);
            if (PASS == 2) {
                const float cin = fq == 0 ? c0 : (fq == 1 ? c1 : (fq == 2 ? c2 : c3));
                aR[n][0] = H0 + A0 * cin; aR[n][1] = H1 + A1 * cin; aR[n][2] = H2 + A2 * cin; aR[n][3] = H3 + A3 * cin;
            }
        }
        if (PASS == 2) {
#pragma unroll
            for (int n = 0; n < 8; ++n)
#pragma unroll
                for (int j = 0; j < 4; j += 2) { const unsigned w = cvt_pk_bf16(aR[n][j], aR[n][j + 1]);
                    *(LAS unsigned short*)(vw + (4 * fq + j) * WROW + (16 * n + fr) * 2) = (unsigned short)(w & 0xffffu);
                    *(LAS unsigned short*)(vw + (4 * fq + j + 1) * WROW + (16 * n + fr) * 2) = (unsigned short)(w >> 16); }
#pragma unroll
            for (int i = 0; i < 4; ++i) {
                const int t = fq + 4 * i; const size_t row = (size_t)(row0 + 16 * st + t);
                const u32x4 hh = *(const LAS u32x4*)(vw + t * WROW + cg * 16);
                const u32x4 g = *(const u32x4*)(p.P2 + row * P2W + h * 128 + cg * 8);
                const f32x4 o0 = (f32x4){bflo(hh.x) * bflo(g.x), bfhi(hh.x) * bfhi(g.x), bflo(hh.y) * bflo(g.y), bfhi(hh.y) * bfhi(g.y)};
                const f32x4 o1 = (f32x4){bflo(hh.z) * bflo(g.z), bfhi(hh.z) * bfhi(g.z), bflo(hh.w) * bflo(g.w), bfhi(hh.w) * bfhi(g.w)};
                *(u32x4*)(p.hl + row * LW + h * 128 + cg * 8) = pack8(o0, o1);
            }
        }
    }
    if (PASS == 1 && fq == 0) {
#pragma unroll
        for (int n = 0; n < 8; ++n) *(f32x2*)(p.summ + (((size_t)b * NCH + c) * LW + h * 128 + 16 * n + fr) * 2) = (f32x2){Arun[n], Hrun[n]};
    }
}

__device__ __forceinline__ void pool_items(LAS unsigned char* lds, LAS unsigned char* vw, int g, int wi, int nw, const MixP& p, int lane);
template <int PASS> __device__ __forceinline__ void lru_pass(LAS unsigned char* lds, const MixP& p, const Args& a, int cv_layer, bf16_t* cv_slot, unsigned* cv_counter) {
    int tid_l = threadIdx.x; asm volatile("" : "+v"(tid_l));
    const int tid = tid_l, lane = tid & 63, wave = __builtin_amdgcn_readfirstlane(tid >> 6);
    const int G = (int)gridDim.x, bid = (int)blockIdx.x, HS = G < 10 ? G : 10;
    LAS unsigned char* vw = lds + VW_OFF + wave * VW_BYTES;
    bool first = true;
    for (int h = bid % HS; h < 10; h += HS) {
        const int nblk = G >= 10 ? (G - h + 9) / 10 : 1, wi = (G >= 10 ? bid / 10 : 0) * 8 + wave, nw = nblk * 8;
        stage_w2(lds, WA_OFF, p.Wa, WX_OFF, p.Wx, LW, h * 128, tid);
        if (PASS == 1 && first) stage_w(lds, WP_OFF, p.Wpool, PW, (bid & 3) * 128, tid);
        if (tid < 128) { LAS float* CP = (LAS float*)(lds + CP_OFF); const int gch = h * 128 + tid;
#pragma unroll
            for (int k = 0; k < 4; ++k) CP[k * 128 + tid] = p.conv_w[k * LW + gch];
            CP[4 * 128 + tid] = p.conv_b[gch]; CP[5 * 128 + tid] = p.b_a[gch]; CP[6 * 128 + tid] = p.b_x[gch];
            CP[7 * 128 + tid] = -8.0f * LOG2E * log1pf(expf(-p.lam[gch])); }
        __syncthreads();
        {
            const int NI = 8 * NCH, jlo = (int)((long)wi * NI / nw), jhi = (int)((long)(wi + 1) * NI / nw); float Hrun[8];
            for (int j = jlo; j < jhi; ++j) lru_wave_item<PASS>(lds, vw, j / NCH, j % NCH, h, p, lane, Hrun, j > jlo && (j % NCH) != 0);
        }
        if (PASS == 1 && first) {
            pool_items(lds, vw, bid & 3, (bid >> 2) * 8 + wave, ((G - (bid & 3) + 3) >> 2) * 8, p, lane);
            if (cv_layer >= 0) convert_dynamic(a, cv_layer, cv_slot, (LAS float*)vw, cv_counter, lane);
        }
        first = false;
        __syncthreads();
    }
}

template <int WIN> __device__ __forceinline__ void pool_subtile(LAS unsigned char* vw, const bf16_t* up  , int s0, int lane) {
    const int cg = lane & 15, tq = lane >> 4, sf = s0 + 4 * tq;
    u32x4 rw[WIN + 3];
#pragma unroll
    for (int r = 0; r < WIN + 3; ++r) { const int sp = sf - (WIN - 1) + r; rw[r] = *(const u32x4*)(up + (size_t)max(sp, 0) * P1W); if (sp < 0) rw[r] = (u32x4){0u, 0u, 0u, 0u}; }
    f32x4 s0v = (f32x4){0.f, 0.f, 0.f, 0.f}, s1v = s0v;
#pragma unroll
    for (int r = 0; r < WIN - 1; ++r) { s0v += (f32x4){bflo(rw[r].x), bfhi(rw[r].x), bflo(rw[r].y), bfhi(rw[r].y)}; s1v += (f32x4){bflo(rw[r].z), bfhi(rw[r].z), bflo(rw[r].w), bfhi(rw[r].w)}; }
#pragma unroll
    for (int jj = 0; jj < 4; ++jj) {
        const u32x4 e = rw[jj + WIN - 1]; const f32x4 e0 = (f32x4){bflo(e.x), bfhi(e.x), bflo(e.y), bfhi(e.y)}, e1 = (f32x4){bflo(e.z), bfhi(e.z), bflo(e.w), bfhi(e.w)};
        s0v += e0; s1v += e1;
        const float inv = 1.0f / (float)min(sf + jj + 1, WIN);
        *(LAS u32x4*)(vw + (4 * tq + jj) * WROW + cg * 16) = pack8(s0v * inv - e0, s1v * inv - e1);
        const u32x4 o = rw[jj]; s0v -= (f32x4){bflo(o.x), bfhi(o.x), bflo(o.y), bfhi(o.y)}; s1v -= (f32x4){bflo(o.z), bfhi(o.z), bflo(o.w), bfhi(o.w)};
    }
}
__device__ __forceinline__ void pool_items(LAS unsigned char* lds, LAS unsigned char* vw, int g, int wi, int nw, const MixP& p, int lane) {
    const int fr = lane & 15, fq = lane >> 4, cg = fr;
    float pb[8], ps[8];
#pragma unroll
    for (int n = 0; n < 8; ++n) { pb[n] = p.pool_b[g * 128 + 16 * n + fr]; ps[n] = p.pool_scale[g * 128 + 16 * n + fr]; }
    for (int j = wi; j < 8 * 64; j += nw) {
        const int b = j >> 6, c32 = j & 63; const bf16_t* up = p.P1 + (size_t)(b * SEQ) * P1W + g * 128 + cg * 8;
#pragma unroll 1
        for (int st = 0; st < 2; ++st) {
            const int s0 = c32 * 32 + 16 * st;
            if (g == 0) pool_subtile<2>(vw, up, s0, lane); else if (g == 1) pool_subtile<4>(vw, up, s0, lane); else if (g == 2) pool_subtile<8>(vw, up, s0, lane); else pool_subtile<16>(vw, up, s0, lane);
            bf16x8 af[4];
#pragma unroll
            for (int kk = 0; kk < 4; ++kk) af[kk] = *(const LAS bf16x8*)(vw + fr * WROW + kk * 64 + fq * 16);
            f32x4 acc[8];
#pragma unroll
            for (int n = 0; n < 8; ++n) { acc[n] = (f32x4){0.f, 0.f, 0.f, 0.f};
#pragma unroll
                for (int kk = 0; kk < 4; ++kk) acc[n] = __builtin_amdgcn_mfma_f32_16x16x32_bf16(af[kk], *(const LAS bf16x8*)(lds + WP_OFF + (16 * n + fr) * WROW + kk * 64 + fq * 16), acc[n], 0, 0, 0); }
#pragma unroll
            for (int n = 0; n < 8; ++n)
#pragma unroll
                for (int jj = 0; jj < 4; jj += 2) { const unsigned w = cvt_pk_bf16((acc[n][jj] + pb[n]) * ps[n], (acc[n][jj + 1] + pb[n]) * ps[n]);
                    *(LAS unsigned short*)(vw + (4 * fq + jj) * WROW + (16 * n + fr) * 2) = (unsigned short)(w & 0xffffu);
                    *(LAS unsigned short*)(vw + (4 * fq + jj + 1) * WROW + (16 * n + fr) * 2) = (unsigned short)(w >> 16); }
#pragma unroll
            for (int i = 0; i < 4; ++i) { const int t = fq + 4 * i;
                *(u32x4*)(p.mixed + (size_t)(b * SEQ + s0 + t) * PW + g * 128 + cg * 8) = *(const LAS u32x4*)(vw + t * WROW + cg * 16); }
        }
    }
}

constexpr int N_LRU = 8 * NCH * 10, N_POOL = 8 * NCH * 4;
#ifndef REP_M2
#define REP_M2 0
#endif
#ifndef REP_SYNC
#define REP_SYNC 0
#endif
#ifndef REP_FA
#define REP_FA 0
#endif
#ifndef REP_FB
#define REP_FB 0
#endif
#ifndef REP_CONV
#define REP_CONV 0
#endif
#ifndef REP_M4
#define REP_M4 0
#endif
#ifndef REP_M5
#define REP_M5 0
#endif
#ifndef REP_M1
#define REP_M1 0
#endif
__global__ void __launch_bounds__(512, 2) fwd_mega(Args a) {
    extern __shared__ __attribute__((aligned(16))) unsigned char lds_raw[];
    LAS unsigned char* lds = (LAS unsigned char*)lds_raw;
    cg::grid_group grid = cg::this_grid();
#define GSYNC() do { asm volatile("s_waitcnt vmcnt(0) lgkmcnt(0)" ::: "memory"); grid.sync(); __builtin_amdgcn_fence(__ATOMIC_ACQUIRE, "agent"); asm volatile("s_waitcnt vmcnt(0)" ::: "memory"); } while (0)
#define LANE_IDS() int tid_l = threadIdx.x; asm volatile("" : "+v"(tid_l)); const int tid = tid_l, lane = tid & 63, wave = __builtin_amdgcn_readfirstlane(tid >> 6), gw = blockIdx.x * 8 + wave, NGW = gridDim.x * 8; (void)gw; (void)NGW; (void)lane
    unsigned char* ws = a.ws;
    bf16_t* Wb = (bf16_t*)(ws + WS_W); bf16_t* XB = (bf16_t*)(ws + WS_XB); bf16_t* R = (bf16_t*)(ws + WS_R);
    bf16_t* P1 = R; bf16_t* P2 = R + (size_t)M * P1W; bf16_t* ACT = R; bf16_t* TB = R;
    bf16_t* MIX = (bf16_t*)(ws + WS_MIX); bf16_t* HL = (bf16_t*)(ws + WS_HL); bf16_t* MRG = (bf16_t*)(ws + WS_MERGED);
    float* SS = (float*)(ws + WS_SS); float* SUMM = (float*)(ws + WS_SUM);

    {
    LANE_IDS();
    if (blockIdx.x == 0) for (int i = tid; i < XCD_BAR_WORDS + 64 + 2048; i += 512) ((unsigned*)(ws + WS_BAR))[i] = 0u;
    if (tid < 8) ((volatile LAS unsigned*)(lds + MISC_OFF))[tid] = tid == 6 ? blockIdx.x : 0u;
    __syncthreads();
    GSYNC();
    if (tid == 0) { const unsigned x = xb_xcc_id(); ((volatile LAS unsigned*)(lds + MISC_OFF))[4] = xb_add(&((unsigned*)(ws + WS_BAR))[XB_XCNT(x)], 1u); }
#define XSYNC() do { unsigned long long off_l = WS_BAR; asm volatile("" : "+s"(off_l)); XcdBarrier bb; bb.bar = (unsigned*)(ws + off_l); bb.x = xb_xcc_id(); asm volatile("" : "+s"(bb.x)); bb.st = (volatile LAS unsigned*)(lds + MISC_OFF); xcd_barrier(bb); } while (0)
    convert_layer(a, 0, Wb, (LAS float*)(lds + VW_OFF + wave * VW_BYTES), gw, NGW, lane);
    for (int row = gw; row < M; row += NGW) {
        const f32x4* xr = (const f32x4*)(a.x + (size_t)row * D) + lane; float s = 0.f;
#pragma unroll
        for (int j = 0; j < 4; ++j) { const f32x4 v = xr[64 * j]; s += (v[0] * v[0] + v[1] * v[1]) + (v[2] * v[2] + v[3] * v[3]);
            u32x2 o; o.x = cvt_pk_bf16(v[0], v[1]); o.y = cvt_pk_bf16(v[2], v[3]); *((u32x2*)(XB + (size_t)row * D) + lane + 64 * j) = o; }
        s = wave_sum(s); if (lane < 16) SS[(size_t)row * 16 + lane] = lane == 0 ? s : 0.f;
    }
    }
    XSYNC();
    if (threadIdx.x == 0) {
        unsigned* bar = (unsigned*)(ws + WS_BAR); const unsigned per = gridDim.x >> 3; bool ok = (gridDim.x & 7u) == 0u;
        for (unsigned j = 0; j < 16; ++j) { const unsigned cnt = xb_ld(&bar[XB_XCNT(j)]); ok = ok && (j < 8 ? cnt == per : cnt == 0u); }
        volatile LAS unsigned* MISC = (volatile LAS unsigned*)(lds + MISC_OFF);
        MISC[5] = ok ? 1u : 0u; MISC[6] = ok ? xb_xcc_id() + 8u * MISC[4] : blockIdx.x;
    }
    __syncthreads();
    const bool xlocal = __builtin_amdgcn_readfirstlane(((volatile LAS int*)(lds + MISC_OFF))[5]) != 0;
#define XSYNC_L() do { if (!xlocal) { XSYNC(); } else { asm volatile("s_waitcnt vmcnt(0)" ::: "memory"); __syncthreads(); \
        if (threadIdx.x == 0) { unsigned long long off_l = WS_LBAR; asm volatile("" : "+s"(off_l)); unsigned* lb = (unsigned*)(ws + off_l); unsigned xx = xb_xcc_id(); asm volatile("" : "+s"(xx)); \
            const unsigned nloc = gridDim.x >> 3, old = xb_add(&lb[64 * xx], 1u), gen = old / nloc; \
            if (old + 1u == (gen + 1u) * nloc) xb_add(&lb[1024 + 64 * xx], 1u); else XB_SPIN(xb_ld(&lb[1024 + 64 * xx]) == gen, (unsigned*)(ws + WS_BAR)); \
            __builtin_amdgcn_fence(__ATOMIC_ACQUIRE, "agent"); asm volatile("s_waitcnt vmcnt(0)" ::: "memory"); } \
        __syncthreads(); } } while (0)

    for (int step = 0; step < 3 * DEPTH; ++step) {
        const int l = step / 3, kind = step - 3 * l;
        bf16_t* slot = Wb + (size_t)(l & 1) * SLOT_ELEMS;
        if (kind != 1) {
            const bf16_t* Wup = slot + (kind == 0 ? OFF_UP1 : OFF_UP2); const bf16_t* Wdn = slot + (kind == 0 ? OFF_DN1 : OFF_DN2);
            for (int rp = 0; rp <= REP_FA; ++rp) {
            { const int pm0 = stage_rstd(lds, SS + (size_t)step * M * 16, 2 * DFF); EpiSwiglu E{ACT, SS + (size_t)step * M * 16, (const LAS float*)(lds + RS_OFF), pm0}; run_gemm(lds, XB, Wup, 2 * DFF, D, E); }
            XSYNC_L(); }
            for (int rp = 0; rp < REP_SYNC; ++rp) XSYNC();
            { EpiResid E{XB, SS + (size_t)(step + 1) * M * 16, 0.5f}; run_gemm(lds, ACT, Wdn, D, DFF, E); }
            if (step == 3 * DEPTH - 1) XSYNC(); else XSYNC_L();
            for (int rp = 0; rp < REP_FB; ++rp) {
            { EpiResid E{XB, SS + (size_t)(step + 1) * M * 16, 0.0f}; run_gemm(lds, ACT, Wdn, D, DFF, E); }
            XSYNC(); }
        } else {
            for (int rp = 0; rp <= REP_M1; ++rp) {
            { const int pm0 = stage_rstd(lds, SS + (size_t)step * M * 16, INW); EpiProj E{P1, P2, SS + (size_t)step * M * 16, (const LAS float*)(lds + RS_OFF), pm0}; run_gemm(lds, XB, slot + OFF_WIN, INW, D, E); }
            XSYNC(); }
            MixP p; p.P1 = P1; p.P2 = P2; p.Wpool = slot + OFF_WPOOL; p.Wa = slot + OFF_WA; p.Wx = slot + OFF_WX; p.mixed = MIX; p.hl = HL; p.summ = SUMM;
            p.pool_b = a.pool_b + l * PW; p.pool_scale = a.pool_scale + l * PW; p.conv_w = a.conv_w + l * 4 * LW; p.conv_b = a.conv_b + l * LW;
            p.b_a = a.lru_b_a + l * LW; p.b_x = a.lru_b_x + l * LW; p.lam = a.lru_lambda + l * LW;
            for (int rp = 0; rp <= REP_M2; ++rp) {
            lru_pass<1>(lds, p, a, (l + 1 < DEPTH && rp == 0) ? l + 1 : -1, Wb + (size_t)((l + 1) & 1) * SLOT_ELEMS, (unsigned*)(ws + WS_CNT) + l);
            if (rp < REP_M2) XSYNC(); }
            XSYNC();
            for (int rp = 0; rp <= REP_M2; ++rp) {
            lru_pass<2>(lds, p, a, -1, nullptr, nullptr);
            XSYNC(); }
            for (int rp = 0; rp <= REP_M4; ++rp) {
            { EpiGateA E{TB, P2 + 1280}; run_gemm(lds, MIX, slot + OFF_WPU, D, PW, E); }
            { EpiGateB E{MRG, TB, P2 + 2304}; run_gemm(lds, HL, slot + OFF_WLU, D, LW, E); }
            XSYNC_L(); }
            { EpiResid E{XB, SS + (size_t)(step + 1) * M * 16, 1.0f}; run_gemm(lds, MRG, slot + OFF_WOUT, D, D, E); }
            XSYNC_L();
            for (int rp = 0; rp < REP_M5; ++rp) {
            { EpiResid E{XB, SS + (size_t)(step + 1) * M * 16, 0.0f}; run_gemm(lds, MRG, slot + OFF_WOUT, D, D, E); }
            XSYNC(); }
        }
    }
    {
        LANE_IDS();
        const float* ssf = SS + (size_t)12 * M * 16;
        f32x4 gv[4];
#pragma unroll
        for (int j = 0; j < 4; ++j) gv[j] = *((const f32x4*)a.final_norm + lane + 64 * j);
        for (int row = gw; row < M; row += NGW) {
            const float rs = row_rstd(ssf, row);
            f32x4* orow = (f32x4*)(a.out + (size_t)row * D) + lane; const u32x2* xr = (const u32x2*)(XB + (size_t)row * D) + lane;
#pragma unroll
            for (int j = 0; j < 4; ++j) { const u32x2 w = xr[64 * j]; orow[64 * j] = (f32x4){bflo(w.x), bfhi(w.x), bflo(w.y), bfhi(w.y)} * rs * gv[j]; }
        }
    }
}

extern "C" void kernel_launch(void* const* d_in, const int* in_sizes, int n_in, void* d_out, int out_size, void* d_ws, size_t ws_size, hipStream_t stream) {
    static int grid = 0;
    if (!grid) {
        int dev = 0, cus = 0, per_cu = 0;
        if (n_in != 23 || out_size != M * D || ws_size < WS_END) { fprintf(stderr, "kernel_launch: unexpected problem: n_in %d out %d ws %zu (need %zu)\n", n_in, out_size, ws_size, (size_t)WS_END); }
        (void)hipGetDevice(&dev);
        (void)hipDeviceGetAttribute(&cus, hipDeviceAttributeMultiprocessorCount, dev);
        (void)hipFuncSetAttribute((const void*)fwd_mega, hipFuncAttributeMaxDynamicSharedMemorySize, LDS_BYTES);
        (void)hipOccupancyMaxActiveBlocksPerMultiprocessor(&per_cu, (const void*)fwd_mega, 512, LDS_BYTES);
        if (per_cu < 1) per_cu = 1;
        grid = cus * per_cu;
    }
    Args a{};
    const float** pp = (const float**)&a;
    for (int i = 0; i < 23; ++i) pp[i] = (const float*)d_in[i];
    a.out = (float*)d_out; a.ws = (unsigned char*)d_ws;
    void* args[] = {&a};
    hipError_t e = hipLaunchCooperativeKernel((const void*)fwd_mega, dim3(grid), dim3(512), args, LDS_BYTES, stream);
    if (e != hipSuccess) fprintf(stderr, "kernel_launch: cooperative launch failed: %s (grid %d)\n", hipGetErrorString(e), grid);
}
```
